# Optimizing an MI355X kernel written in HIP

```python
import math
import jax, jax.numpy as jnp
from jax import lax
import numpy as np

D_MODEL = 1024
BATCH = 8
SEQ = 4096
DEPTH = 4

POOL_WINDOWS = (2, 4, 8, 16)
N_POOL_GROUPS = 4
POOL_GROUP_DIM = 64
POOL_WIDTH = N_POOL_GROUPS * POOL_GROUP_DIM
DIFF_HEADS = 6
DIFF_HEAD_DIM = 64
DIFF_V_DIM = 2 * DIFF_HEAD_DIM
DIFF_QK = 2 * DIFF_HEADS * DIFF_HEAD_DIM
DIFF_WIDTH = DIFF_HEADS * DIFF_V_DIM
DIFF_QBLOCK = 128
CONV_CH = 256
CONV_WIDTH = 31
MOBA_HEADS = 6
MOBA_HEAD_DIM = 128
MOBA_WIDTH = MOBA_HEADS * MOBA_HEAD_DIM
MOBA_BLOCK = 256
MOBA_TOPK = 3
MOBA_QCHUNK = 16
MIX_WIDTH = POOL_WIDTH + DIFF_WIDTH
AB_IN = POOL_WIDTH + 2 * DIFF_QK + DIFF_WIDTH
CD_IN = 2 * CONV_CH + 3 * MOBA_WIDTH
D_FF = -(-8 * D_MODEL // (3 * 256)) * 256
N_AB = (DEPTH + 1) // 2
N_CD = DEPTH // 2
EPS = 1e-6
NEG = -1e30

kernel_name = "hybrid_pool_diffattn_conformer_moba_trunk"


def rms_norm(x, g):
    x32 = x.astype(jnp.float32)
    y = x32 * lax.rsqrt(jnp.mean(jnp.square(x32), axis=-1, keepdims=True) + EPS)
    return (y * g).astype(x.dtype)


def layer_norm(x, g, b):
    x32 = x.astype(jnp.float32)
    mu = jnp.mean(x32, axis=-1, keepdims=True)
    var = jnp.mean(jnp.square(x32 - mu), axis=-1, keepdims=True)
    return ((x32 - mu) * lax.rsqrt(var + EPS) * g + b).astype(x.dtype)


def multiscale_pool(u, w_groups, scale):
    B_, S, _ = u.shape
    u32 = u.astype(jnp.float32)
    cs = jnp.cumsum(u32, axis=1)
    cs = jnp.concatenate([jnp.zeros_like(cs[:, :1]), cs], axis=1)
    pos = jnp.arange(S)
    outs = []
    for g, w in enumerate(POOL_WINDOWS):
        sl = slice(g * POOL_GROUP_DIM, (g + 1) * POOL_GROUP_DIM)
        c = cs[:, :, sl]
        upper = c[:, 1:]
        lower = jnp.pad(c, ((0, 0), (w - 1, 0), (0, 0)))[:, :S]
        cnt = jnp.minimum(pos + 1, w).astype(jnp.float32)[None, :, None]
        outs.append((upper - lower) / cnt - u32[:, :, sl])
    d = jnp.stack(outs, axis=2).astype(u.dtype)
    y = jnp.einsum('bsgc,gcd->bsgd', d, w_groups)
    return y.reshape(B_, S, POOL_WIDTH) * scale


def diff_attention(q, k, v, lam_params, subln_g, lam_init):
    B_, S = q.shape[:2]
    lp = lam_params.astype(jnp.float32)
    lam = jnp.exp(jnp.sum(lp[0] * lp[1])) - jnp.exp(jnp.sum(lp[2] * lp[3])) + lam_init
    kh = k.transpose(0, 2, 1, 3)
    vh = v.transpose(0, 2, 1, 3)
    nblk = S // DIFF_QBLOCK
    qb = q.reshape(B_, nblk, DIFF_QBLOCK, 2 * DIFF_HEADS, DIFF_HEAD_DIM).transpose(1, 0, 3, 2, 4)
    key_pos = jnp.arange(S)
    scale = DIFF_HEAD_DIM ** -0.5

    def block(args):
        q_blk, bi = args
        s = jnp.einsum('bhqd,bhkd->bhqk', q_blk, kh).astype(jnp.float32) * scale
        q_pos = bi * DIFF_QBLOCK + jnp.arange(DIFF_QBLOCK)
        s = jnp.where(key_pos[None, :] <= q_pos[:, None], s, NEG)
        p = jax.nn.softmax(s, axis=-1).reshape(B_, DIFF_HEADS, 2, DIFF_QBLOCK, S)
        a = p[:, :, 0] - lam * p[:, :, 1]
        return jnp.einsum('bhqk,bhkd->bhqd', a.astype(vh.dtype), vh)

    o = lax.map(block, (qb, jnp.arange(nblk)))
    o = rms_norm(o, subln_g) * (1.0 - lam_init)
    return o.transpose(1, 0, 3, 2, 4).reshape(B_, S, DIFF_WIDTH)


def conformer_conv(u, conv_w, conv_b, ln_g, ln_b):
    h = u[..., :CONV_CH] * jax.nn.sigmoid(u[..., CONV_CH:])
    h = lax.conv_general_dilated(
        h, conv_w[:, None, :], window_strides=(1,), padding=[(CONV_WIDTH - 1, 0)],
        dimension_numbers=('NWC', 'WIO', 'NWC'), feature_group_count=CONV_CH) + conv_b
    return jax.nn.silu(layer_norm(h, ln_g, ln_b))


def moba_attention(q, k, v):
    B_, S = q.shape[:2]
    Sp = -(-S // MOBA_BLOCK) * MOBA_BLOCK
    pad = ((0, 0), (0, Sp - S), (0, 0), (0, 0))
    q, k, v = [jnp.pad(t, pad).transpose(0, 2, 1, 3) for t in (q, k, v)]
    nb = Sp // MOBA_BLOCK
    topk = min(MOBA_TOPK, nb)
    k_blocks = k.reshape(B_, MOBA_HEADS, nb, MOBA_BLOCK, MOBA_HEAD_DIM)
    v_blocks = v.reshape(B_, MOBA_HEADS, nb, MOBA_BLOCK, MOBA_HEAD_DIM)
    k_mean = jnp.mean(k_blocks.astype(jnp.float32), axis=3).astype(k.dtype)
    nch = Sp // MOBA_QCHUNK
    qc = q.reshape(B_, MOBA_HEADS, nch, MOBA_QCHUNK, MOBA_HEAD_DIM).transpose(2, 0, 1, 3, 4)
    b_idx = jnp.arange(B_)[:, None, None, None]
    h_idx = jnp.arange(MOBA_HEADS)[None, :, None, None]
    blk_ids = jnp.arange(nb)
    own_off = jnp.arange(MOBA_BLOCK)
    scale = MOBA_HEAD_DIM ** -0.5

    def chunk(args):
        q_c, ci = args
        start = ci * MOBA_QCHUNK
        i = start // MOBA_BLOCK
        q_pos = start + jnp.arange(MOBA_QCHUNK)
        gate = jnp.einsum('bhqd,bhnd->bhqn', q_c, k_mean).astype(jnp.float32)
        gate = jnp.where(blk_ids < i, gate, NEG)
        _, idx = lax.top_k(gate, topk)
        valid = idx < i
        k_sel = k_blocks[b_idx, h_idx, idx]
        v_sel = v_blocks[b_idx, h_idx, idx]
        s_sel = jnp.einsum('bhqd,bhqjkd->bhqjk', q_c, k_sel).astype(jnp.float32) * scale
        s_sel = jnp.where(valid[..., None], s_sel, NEG).reshape(B_, MOBA_HEADS, MOBA_QCHUNK, topk * MOBA_BLOCK)
        k_own = lax.dynamic_slice_in_dim(k, i * MOBA_BLOCK, MOBA_BLOCK, axis=2)
        v_own = lax.dynamic_slice_in_dim(v, i * MOBA_BLOCK, MOBA_BLOCK, axis=2)
        s_own = jnp.einsum('bhqd,bhkd->bhqk', q_c, k_own).astype(jnp.float32) * scale
        s_own = jnp.where(i * MOBA_BLOCK + own_off[None, :] <= q_pos[:, None], s_own, NEG)
        p = jax.nn.softmax(jnp.concatenate([s_sel, s_own], axis=-1), axis=-1)
        p_sel = p[..., :topk * MOBA_BLOCK].reshape(B_, MOBA_HEADS, MOBA_QCHUNK, topk, MOBA_BLOCK).astype(v.dtype)
        p_own = p[..., topk * MOBA_BLOCK:].astype(v.dtype)
        return (jnp.einsum('bhqjk,bhqjkd->bhqd', p_sel, v_sel)
                + jnp.einsum('bhqk,bhkd->bhqd', p_own, v_own))

    o = lax.map(chunk, (qc, jnp.arange(nch)))
    return o.transpose(1, 0, 3, 2, 4).reshape(B_, Sp, MOBA_WIDTH)[:, :S]


def setup_inputs(seed: int = 0) -> dict:
    key = jax.random.key(seed)
    ks = jax.random.split(key, 20)
    f32 = jnp.float32

    def nrm(k, shape, s):
        return jax.random.normal(k, shape, f32) * s

    return {
        "x": nrm(ks[0], (BATCH, SEQ, D_MODEL), 1.0),
        "norm_mix_g": 1.0 + nrm(ks[1], (DEPTH, D_MODEL), 0.02),
        "norm_ffn_g": 1.0 + nrm(ks[2], (DEPTH, D_MODEL), 0.02),
        "norm_final_g": 1.0 + nrm(ks[3], (D_MODEL,), 0.02),
        "ab_w_in": nrm(ks[4], (N_AB, D_MODEL, AB_IN), D_MODEL ** -0.5),
        "ab_w_out": nrm(ks[5], (N_AB, MIX_WIDTH, D_MODEL), MIX_WIDTH ** -0.5),
        "pool_w": nrm(ks[6], (N_AB, N_POOL_GROUPS, POOL_GROUP_DIM, POOL_GROUP_DIM), POOL_GROUP_DIM ** -0.5),
        "pool_scale": 1.0 + nrm(ks[7], (N_AB, POOL_WIDTH), 0.02),
        "diff_lambda": nrm(ks[8], (N_AB, 4, DIFF_HEAD_DIM), 0.1),
        "diff_subln_g": 1.0 + nrm(ks[9], (N_AB, DIFF_V_DIM), 0.02),
        "cd_w_in": nrm(ks[10], (N_CD, D_MODEL, CD_IN), D_MODEL ** -0.5),
        "cd_w_out": nrm(ks[11], (N_CD, MIX_WIDTH, D_MODEL), MIX_WIDTH ** -0.5),
        "conv_w": nrm(ks[12], (N_CD, CONV_WIDTH, CONV_CH), CONV_WIDTH ** -0.5),
        "conv_b": nrm(ks[13], (N_CD, CONV_CH), 0.02),
        "conv_ln_g": 1.0 + nrm(ks[14], (N_CD, CONV_CH), 0.02),
        "conv_ln_b": nrm(ks[15], (N_CD, CONV_CH), 0.02),
        "ffn_w_gate": nrm(ks[16], (DEPTH, D_MODEL, D_FF), D_MODEL ** -0.5),
        "ffn_w_up": nrm(ks[17], (DEPTH, D_MODEL, D_FF), D_MODEL ** -0.5),
        "ffn_w_down": nrm(ks[18], (DEPTH, D_FF, D_MODEL), D_FF ** -0.5),
    }


def reference(x, norm_mix_g, norm_ffn_g, norm_final_g, ab_w_in, ab_w_out, pool_w, pool_scale,
              diff_lambda, diff_subln_g, cd_w_in, cd_w_out, conv_w, conv_b, conv_ln_g, conv_ln_b,
              ffn_w_gate, ffn_w_up, ffn_w_down):
    B_, S, _ = x.shape
    h = x
    for layer in range(DEPTH):
        xn = rms_norm(h, norm_mix_g[layer])
        j = layer // 2
        if layer % 2 == 0:
            proj = xn @ ab_w_in[j]
            o = POOL_WIDTH
            u_pool = proj[..., :o]
            q = proj[..., o:o + DIFF_QK].reshape(B_, S, 2 * DIFF_HEADS, DIFF_HEAD_DIM)
            k = proj[..., o + DIFF_QK:o + 2 * DIFF_QK].reshape(B_, S, 2 * DIFF_HEADS, DIFF_HEAD_DIM)
            v = proj[..., o + 2 * DIFF_QK:].reshape(B_, S, DIFF_HEADS, DIFF_V_DIM)
            lam_init = 0.8 - 0.6 * math.exp(-0.3 * layer)
            y_a = multiscale_pool(u_pool, pool_w[j], pool_scale[j])
            y_b = diff_attention(q, k, v, diff_lambda[j], diff_subln_g[j], lam_init)
            mix = jnp.concatenate([y_a, y_b], axis=-1) @ ab_w_out[j]
        else:
            proj = xn @ cd_w_in[j]
            o = 2 * CONV_CH
            u_conv = proj[..., :o]
            q = proj[..., o:o + MOBA_WIDTH].reshape(B_, S, MOBA_HEADS, MOBA_HEAD_DIM)
            k = proj[..., o + MOBA_WIDTH:o + 2 * MOBA_WIDTH].reshape(B_, S, MOBA_HEADS, MOBA_HEAD_DIM)
            v = proj[..., o + 2 * MOBA_WIDTH:].reshape(B_, S, MOBA_HEADS, MOBA_HEAD_DIM)
            y_c = conformer_conv(u_conv, conv_w[j], conv_b[j], conv_ln_g[j], conv_ln_b[j])
            y_d = moba_attention(q, k, v)
            mix = jnp.concatenate([y_c, y_d], axis=-1) @ cd_w_out[j]
        h = h + mix
        hn = rms_norm(h, norm_ffn_g[layer])
        h = h + (jax.nn.silu(hn @ ffn_w_gate[layer]) * (hn @ ffn_w_up[layer])) @ ffn_w_down[layer]
    return rms_norm(h, norm_final_g)
```

```cpp
#include <hip/hip_runtime.h>
#include <hip/hip_cooperative_groups.h>
#include <cstdio>
#include <cstdint>
namespace cg = cooperative_groups;

#ifndef MK_MULTI
#define MK_MULTI 0
#endif

#ifndef X_SUB
#define X_SUB 0
#endif
#ifndef X_REP
#define X_REP 0
#endif

#define LAS __attribute__((address_space(3)))
typedef unsigned short bf16_t;
typedef short bf16x8 __attribute__((ext_vector_type(8)));
typedef short s16x4 __attribute__((ext_vector_type(4)));
typedef float f32x4 __attribute__((ext_vector_type(4)));
typedef float f32x2 __attribute__((ext_vector_type(2)));
typedef unsigned u32x4 __attribute__((ext_vector_type(4)));
typedef unsigned u32x2 __attribute__((ext_vector_type(2)));
typedef __bf16 bf16x2_t __attribute__((ext_vector_type(2)));

constexpr int D = 1024, BATCH = 8, SEQ = 4096, M = BATCH * SEQ, DEPTH = 4;
constexpr int AB_IN = 2560, CD_IN = 2816, DFF = 2816;
constexpr float EPS = 1e-6f;
constexpr int NWAVES = 8, NTHR = 512;
constexpr int LDS_BYTES = 147456;

constexpr size_t MiB = 1u << 20;
constexpr size_t WS_SS = 444 * MiB;
constexpr size_t WS_BAR = 0;
constexpr size_t WS_KMH = 2 * MiB, WS_KML = 2 * MiB + 256 * 1024;
constexpr size_t WS_W = 4 * MiB, WS_WL = 26 * MiB;
constexpr size_t WO_IN = 0, WO_OUT = 6 * MiB, WO_GU = 8 * MiB, WO_D = 19 * MiB;
constexpr size_t WS_HBF = 108 * MiB;
constexpr size_t WS_MIX = 172 * MiB;
constexpr size_t WS_PROJ = 236 * MiB;
constexpr size_t WS_O1 = 412 * MiB;
constexpr size_t WS_END = 462 * MiB;

__device__ __forceinline__ unsigned cvtpk(float lo, float hi) { f32x2 v = {lo, hi}; bf16x2_t b = __builtin_convertvector(v, bf16x2_t); return __builtin_bit_cast(unsigned, b); }
__device__ __forceinline__ float bflo(unsigned u) { return __builtin_bit_cast(float, u << 16); }
__device__ __forceinline__ float bfhi(unsigned u) { return __builtin_bit_cast(float, u & 0xffff0000u); }
__device__ __forceinline__ float shx(float v, int m, int lane) { return __builtin_bit_cast(float, __builtin_amdgcn_ds_bpermute((lane ^ m) << 2, __builtin_bit_cast(int, v))); }
__device__ __forceinline__ float wave_sum(float v, int lane) {
#pragma unroll
    for (int o = 1; o < 64; o <<= 1) v += shx(v, o, lane);
    return v;
}
__device__ __forceinline__ float fast_sigmoid(float x) { return __builtin_amdgcn_rcpf(1.f + __builtin_amdgcn_exp2f(-1.4426950408889634f * x)); }

__device__ __forceinline__ float row_rstd(const float* ss, int row) {
    const f32x4* p = (const f32x4*)(ss + (size_t)row * 16);
    const f32x4 a = p[0], b = p[1], c = p[2], d = p[3];
    const float s = ((a[0] + a[1]) + (a[2] + a[3])) + ((b[0] + b[1]) + (b[2] + b[3])) + (((c[0] + c[1]) + (c[2] + c[3])) + ((d[0] + d[1]) + (d[2] + d[3])));
    return __builtin_amdgcn_rsqf(s * (1.f / D) + EPS);
}

namespace pg8 {
constexpr int BM = 256, BK = 64, HALF = 128, HTB = HALF * BK * 2, NXCD = 8, WGM = 8;
__host__ __device__ __forceinline__ int lds_byte(int r, int c) { const int st = (r >> 4) * 2 + (c >> 5), rr = r & 15, cc = c & 31, ob = rr * 64 + cc * 2; return st * 1024 + (ob ^ (((ob >> 9) & 1) << 5)); }
__host__ __device__ __forceinline__ void stage_rc(int b, int& R, int& C) { const int st = b / 1024, sb = b % 1024, swz = sb ^ (((sb >> 9) & 1) << 5); R = (st >> 1) * 16 + swz / 64; C = (st & 1) * 32 + (swz % 64) / 2; }
__host__ __device__ __forceinline__ int perm32(int rho) { const int n = rho >> 4, i = rho & 15; return 8 * (i >> 2) + 4 * n + (i & 3); }

struct Unit { int pm, pn; };
struct Gemm { const bf16_t* A; const bf16_t* Bt; int M, N, K; };

struct StaticOrder {
    int nM, nN, nwg, G, c;
    __device__ void init(int M_, int N_, int G_, int c_) { nM = M_ / BM; nN = N_ / BM; nwg = nM * nN; G = G_; c = c_; }
    __device__ bool next(int i, Unit& u) const {
        const long L = (long)i * G + c; if (L >= nwg) return false;
        int wgid = (int)L; { const int q = nwg / NXCD, r = nwg % NXCD, xcd = wgid % NXCD, off = wgid / NXCD; wgid = (xcd < r ? xcd * (q + 1) : r * (q + 1) + (xcd - r) * q) + off; }
        const int nig = WGM * nN, gid = wgid / nig, fm = gid * WGM, gsz = (nM - fm) < WGM ? (nM - fm) : WGM;
        u.pm = fm + ((wgid % nig) % gsz); u.pn = (wgid % nig) / gsz; return true;
    }
};


struct EpiProj {
    static constexpr bool PRE = true;
    bf16_t* O; int ldc; const float* ss;
    __device__ __forceinline__ void operator()(const f32x4 (&acc)[2][2][4][2], const Unit& u, const LAS float* rt, int wr, int wc, int fr, int fq) const {
        const int row0 = u.pm * BM + wr * 64 + fr, col0 = u.pn * BM + wc * 32 + 8 * fq;
#pragma unroll
        for (int ai = 0; ai < 2; ++ai)
#pragma unroll
            for (int m = 0; m < 4; ++m) {
                const int row = row0 + ai * HALF + m * 16;
                const float r = rt[wr * 64 + fr + ai * HALF + m * 16];
                bf16_t* rowp = O + (size_t)row * ldc + col0;
#pragma unroll
                for (int bj = 0; bj < 2; ++bj) {
                    const f32x4 v0 = acc[ai][bj][m][0] * r, v1 = acc[ai][bj][m][1] * r;
                    u32x4 w; w.x = cvtpk(v0[0], v0[1]); w.y = cvtpk(v0[2], v0[3]); w.z = cvtpk(v1[0], v1[1]); w.w = cvtpk(v1[2], v1[3]);
                    *(u32x4*)(rowp + bj * HALF) = w;
                }
            }
    }
};
struct EpiRes {
    static constexpr bool PRE = false;
    bf16_t* HB; float* ssout;
    __device__ __forceinline__ void operator()(const f32x4 (&acc)[2][2][4][2], const Unit& u, const LAS float*, int wr, int wc, int fr, int fq) const {
        const int row0 = u.pm * BM + wr * 64 + fr, col0 = u.pn * BM + wc * 32 + 8 * fq;
#pragma unroll
        for (int ai = 0; ai < 2; ++ai) {
            u32x4 rv[4][2];
#pragma unroll
            for (int m = 0; m < 4; ++m)
#pragma unroll
                for (int bj = 0; bj < 2; ++bj) rv[m][bj] = *(const u32x4*)(HB + (size_t)(row0 + ai * HALF + m * 16) * D + col0 + bj * HALF);
            __builtin_amdgcn_sched_barrier(0);
#pragma unroll
            for (int m = 0; m < 4; ++m) {
                const int row = row0 + ai * HALF + m * 16;
                float sq = 0.f;
#pragma unroll
                for (int bj = 0; bj < 2; ++bj) {
                    const size_t off = (size_t)row * D + col0 + bj * HALF;
                    const u32x4 r = rv[m][bj];
                    const f32x4 v0 = acc[ai][bj][m][0] + (f32x4){bflo(r.x), bfhi(r.x), bflo(r.y), bfhi(r.y)}, v1 = acc[ai][bj][m][1] + (f32x4){bflo(r.z), bfhi(r.z), bflo(r.w), bfhi(r.w)};
                    u32x4 w; w.x = cvtpk(v0[0], v0[1]); w.y = cvtpk(v0[2], v0[3]); w.z = cvtpk(v1[0], v1[1]); w.w = cvtpk(v1[2], v1[3]);
                    *(u32x4*)(HB + off) = w;
                    sq += v0[0] * v0[0] + v0[1] * v0[1] + v0[2] * v0[2] + v0[3] * v0[3] + v1[0] * v1[0] + v1[1] * v1[1] + v1[2] * v1[2] + v1[3] * v1[3];
                }
                sq += shx(sq, 16, fr + 16 * fq); sq += shx(sq, 32, fr + 16 * fq);
                if (fq == 0) ssout[(size_t)row * 16 + u.pn * 4 + wc] = sq;
            }
            __builtin_amdgcn_sched_barrier(0);
        }
    }
};
struct EpiGlu {
    static constexpr bool PRE = true;
    bf16_t* O; const float* ss;
    __device__ __forceinline__ void operator()(const f32x4 (&acc)[2][2][4][2], const Unit& u, const LAS float* rt, int wr, int wc, int fr, int fq) const {
        const int row0 = u.pm * BM + wr * 64 + fr, col0 = u.pn * HALF + wc * 32 + 8 * fq;
#pragma unroll
        for (int ai = 0; ai < 2; ++ai)
#pragma unroll
            for (int m = 0; m < 4; ++m) {
                const int row = row0 + ai * HALF + m * 16;
                const float r = rt[wr * 64 + fr + ai * HALF + m * 16];
                float o[8];
#pragma unroll
                for (int n = 0; n < 2; ++n)
#pragma unroll
                    for (int j = 0; j < 4; ++j) { const float g = acc[ai][0][m][n][j] * r, uu = acc[ai][1][m][n][j] * r; o[4 * n + j] = g * fast_sigmoid(g) * uu; }
                u32x4 w; w.x = cvtpk(o[0], o[1]); w.y = cvtpk(o[2], o[3]); w.z = cvtpk(o[4], o[5]); w.w = cvtpk(o[6], o[7]);
                *(u32x4*)(O + (size_t)row * DFF + col0) = w;
            }
    }
};

template <class Epi, int KC>
__device__ __forceinline__ void gemm_phase(const int tid, LAS unsigned char* lds, const Gemm g, const StaticOrder& S, const Epi& E) {
    const int wid = __builtin_amdgcn_readfirstlane(tid >> 6), lane = tid & 63, wr = wid >> 2, wc = wid & 3, fr = lane & 15, fq = lane >> 4;
    constexpr int K = KC, nt = K / BK;
    unsigned voffA[2], voffB[2];
#pragma unroll
    for (int i = 0; i < 2; ++i) { int R, C; stage_rc(tid * 16 + i * 8192, R, C); const int Rb = (R & ~31) + perm32(R & 31);
        voffA[i] = (unsigned)(R * K + C) * 2u; voffB[i] = (unsigned)(Rb * K + C) * 2u; }
    const size_t kstep = (size_t)(BK * 2);
    const size_t hstep = (size_t)HALF * K * 2;
    const size_t tstep = 2 * hstep;
    const unsigned ldsw = (unsigned)wid * 1024u;
    const int aoff = lds_byte(wr * 64 + fr, fq * 8), boff = lds_byte(wc * 32 + fr, fq * 8);
#define PG8_SA(b, h) (((b) * 2 + (h)) * HTB)
#define PG8_SB(b, h) ((4 + (b) * 2 + (h)) * HTB)
#define PG8_STAGE(bufoff, gbase, voff) do { _Pragma("unroll") for (int _i = 0; _i < 2; ++_i) \
        __builtin_amdgcn_global_load_lds((const unsigned*)((const char*)(gbase) + (voff)[_i]), (LAS unsigned*)(lds + (bufoff) + ldsw + _i * 8192), 16, 0, 0); } while (0)
#define PG8_LDA(dst, b, h) do { _Pragma("unroll") for (int m = 0; m < 4; ++m) _Pragma("unroll") for (int k = 0; k < 2; ++k) dst[m][k] = *(const LAS bf16x8*)(lds + PG8_SA(b, h) + aoff + m * 2048 + k * 1024); } while (0)
#define PG8_LDB(dst, b, h) do { _Pragma("unroll") for (int n = 0; n < 2; ++n) _Pragma("unroll") for (int k = 0; k < 2; ++k) dst[n][k] = *(const LAS bf16x8*)(lds + PG8_SB(b, h) + boff + n * 2048 + k * 1024); } while (0)
#define PG8_MMA(ai, bj, At, Bt) do { __builtin_amdgcn_s_setprio(1); _Pragma("unroll") for (int m = 0; m < 4; ++m) _Pragma("unroll") for (int n = 0; n < 2; ++n) _Pragma("unroll") for (int k = 0; k < 2; ++k) \
        acc[ai][bj][m][n] = __builtin_amdgcn_mfma_f32_16x16x32_bf16(Bt[n][k], At[m][k], acc[ai][bj][m][n], 0, 0, 0); __builtin_amdgcn_s_setprio(0); } while (0)
#define PG8_WAIT_V(n) asm volatile("s_waitcnt vmcnt(" #n ")" ::: "memory")
#define PG8_WAIT_L(n) asm volatile("s_waitcnt lgkmcnt(" #n ")" ::: "memory")
#define PG8_BAR __builtin_amdgcn_s_barrier()
#define PG8_SCHED __builtin_amdgcn_sched_barrier(0)
    Unit cur, nxt; int ui = 0;
    if (!S.next(0, cur)) return;
    LAS float* rtab = (LAS float*)(lds + 131072);
    f32x4 acc[2][2][4][2];
#pragma unroll
    for (int a = 0; a < 2; ++a)
#pragma unroll
        for (int b = 0; b < 2; ++b)
#pragma unroll
            for (int m = 0; m < 4; ++m)
#pragma unroll
                for (int n = 0; n < 2; ++n) acc[a][b][m][n] = (f32x4){0.f, 0.f, 0.f, 0.f};
    bf16x8 At[4][2], B0[2][2], B1[2][2];
    const char* cA = (const char*)g.A + (size_t)cur.pm * tstep; const char* cB = (const char*)g.Bt + (size_t)cur.pn * tstep;
    PG8_STAGE(PG8_SB(0, 0), cB, voffB); PG8_STAGE(PG8_SB(0, 1), cB + hstep, voffB); PG8_STAGE(PG8_SA(0, 0), cA, voffA); PG8_STAGE(PG8_SA(0, 1), cA + hstep, voffA);
    if constexpr (Epi::PRE) {
        Unit u2;
        for (int i = 0; S.next(i + (tid >> 8), u2) ; i += 2) rtab[(i + (tid >> 8)) * 256 + (tid & 255)] = row_rstd(E.ss, u2.pm * BM + (tid & 255));
        __syncthreads();
    }
    if (wr == 1) PG8_BAR;
    PG8_WAIT_V(2); PG8_BAR;
    PG8_STAGE(PG8_SB(1, 0), cB + kstep, voffB); PG8_STAGE(PG8_SA(1, 0), cA + kstep, voffA); PG8_STAGE(PG8_SB(1, 1), cB + hstep + kstep, voffB);
    PG8_WAIT_V(6); PG8_BAR;
    for (;;) {
        const bool has_next = S.next(ui + 1, nxt);
        const char* nA = has_next ? (const char*)g.A + (size_t)nxt.pm * tstep : cA; const char* nB = has_next ? (const char*)g.Bt + (size_t)nxt.pn * tstep : cB;
        for (int t = 0; t < nt; t += 2) {
            const bool last = (t == nt - 2);
            const char* a1 = cA + (size_t)(t + 1) * kstep;
            const char* a2 = last ? nA : cA + (size_t)(t + 2) * kstep; const char* b2 = last ? nB : cB + (size_t)(t + 2) * kstep;
            const char* a3 = a2 + kstep; const char* b3 = b2 + kstep;
            PG8_LDB(B0, 0, 0); PG8_LDB(B1, 0, 1); PG8_SCHED; PG8_LDA(At, 0, 0); PG8_STAGE(PG8_SA(1, 1), a1 + hstep, voffA);
            PG8_WAIT_V(8); PG8_WAIT_L(0); PG8_BAR; PG8_MMA(0, 0, At, B0); PG8_MMA(0, 1, At, B1); PG8_BAR; PG8_SCHED;
            PG8_LDA(At, 0, 1); PG8_STAGE(PG8_SB(0, 0), b2, voffB); PG8_STAGE(PG8_SB(0, 1), b2 + hstep, voffB); PG8_STAGE(PG8_SA(0, 0), a2, voffA);
            PG8_WAIT_V(8); PG8_WAIT_L(0); PG8_BAR; PG8_MMA(1, 0, At, B0); PG8_MMA(1, 1, At, B1); PG8_BAR; PG8_SCHED;
            PG8_LDB(B0, 1, 0); PG8_LDB(B1, 1, 1); PG8_SCHED; PG8_LDA(At, 1, 0); PG8_STAGE(PG8_SA(0, 1), a2 + hstep, voffA);
            PG8_WAIT_V(8); PG8_WAIT_L(0); PG8_BAR; PG8_MMA(0, 0, At, B0); PG8_MMA(0, 1, At, B1); PG8_BAR; PG8_SCHED;
            PG8_LDA(At, 1, 1); PG8_STAGE(PG8_SB(1, 0), b3, voffB); PG8_STAGE(PG8_SB(1, 1), b3 + hstep, voffB); PG8_STAGE(PG8_SA(1, 0), a3, voffA);
            PG8_WAIT_V(8); PG8_WAIT_L(0); PG8_BAR; PG8_MMA(1, 0, At, B0); PG8_MMA(1, 1, At, B1); PG8_BAR; PG8_SCHED;
        }
        if (wr == 0) PG8_BAR;
        E(acc, cur, rtab + ui * 256, wr, wc, fr, fq);
        if (!has_next) break;
#pragma unroll
        for (int a = 0; a < 2; ++a)
#pragma unroll
            for (int b = 0; b < 2; ++b)
#pragma unroll
                for (int m = 0; m < 4; ++m)
#pragma unroll
                    for (int n = 0; n < 2; ++n) acc[a][b][m][n] = (f32x4){0.f, 0.f, 0.f, 0.f};
        cur = nxt; cA = nA; cB = nB; ++ui;
        if (wr == 1) PG8_BAR;
    }
    PG8_WAIT_V(0);
    PG8_BAR;
#undef PG8_SA
#undef PG8_SB
#undef PG8_STAGE
#undef PG8_LDA
#undef PG8_LDB
#undef PG8_MMA
#undef PG8_WAIT_V
#undef PG8_WAIT_L
#undef PG8_BAR
#undef PG8_SCHED
}
}

__device__ __forceinline__ int dest_row(int n, int rowmode) { return rowmode == 0 ? n : ((n >> 7) * 256 + (n & 127) + (rowmode == 2 ? 128 : 0)); }
__device__ __forceinline__ void tile_load(const float* W, int ldw, const float* kscale, int k0, int n0, LAS float* scr, int lane, float cs = 1.f) {
    float wv[32];
#pragma unroll
    for (int i = 0; i < 32; ++i) wv[i] = W[(size_t)(k0 + 2 * i + (lane >> 5)) * ldw + n0 + (lane & 31)];
#pragma unroll
    for (int i = 0; i < 32; ++i) { const int kk = 2 * i + (lane >> 5); float v = wv[i] * cs; if (kscale) v *= kscale[k0 + kk]; scr[kk * 33 + (lane & 31)] = v; }
    asm volatile("s_waitcnt lgkmcnt(0)" ::: "memory");
}
__device__ __forceinline__ void tile_store_t(const LAS float* scr, bf16_t* WT, int ldt, int k0, int n0, int rowmode, int lane) {
    const int c = lane & 7;
#pragma unroll
    for (int j = 0; j < 4; ++j) { const int n = (lane >> 3) + 8 * j; const LAS float* s = scr + (8 * c) * 33 + n;
        u32x4 o; o.x = cvtpk(s[0 * 33], s[1 * 33]); o.y = cvtpk(s[2 * 33], s[3 * 33]); o.z = cvtpk(s[4 * 33], s[5 * 33]); o.w = cvtpk(s[6 * 33], s[7 * 33]);
        *(u32x4*)(WT + (size_t)dest_row(n0 + n, rowmode) * ldt + k0 + 8 * c) = o; }
    asm volatile("s_waitcnt lgkmcnt(0)" ::: "memory");
}

constexpr int AT_VP = 288;
constexpr int AT_KS = 0, AT_VS = 18432, AT_BUF = 36864, AT_KMH = 73728, AT_KML = 78080;
__device__ __forceinline__ s16x4 vtr(const LAS unsigned char* p) { return __builtin_bit_cast(s16x4, __builtin_amdgcn_ds_read_tr16_b64_v4i16((LAS s16x4*)p)); }

template <int DQK, bool MOBA>
__device__ __forceinline__ void attn_pass(const int tid, LAS unsigned char* lds, const bf16_t* Pb  , int ld, int qcol, int kcol, int vcol,
                                          int q0, int blk, const bf16_t* kmh, const bf16_t* kml, f32x4 (&O)[2][8], float (&linv)[2]) {
    constexpr int PK = (DQK == 64) ? 160 : 288  , NKS = DQK / 32, KCH = DQK / 8  , NKL = DQK / 64  ;
    const int lane = tid & 63, wid = __builtin_amdgcn_readfirstlane(tid >> 6), l15 = lane & 15, quad = lane >> 4;
    const int qw0 = q0 + 32 * wid;
    bf16x8 Qf[2][NKS];
#pragma unroll
    for (int qt = 0; qt < 2; ++qt)
#pragma unroll
        for (int ks = 0; ks < NKS; ++ks) Qf[qt][ks] = *(const bf16x8*)(Pb + (size_t)(qw0 + 16 * qt + l15) * ld + qcol + 32 * ks + 8 * quad);
    float mu[2] = {0.f, 0.f}, l[2] = {0.f, 0.f};
#pragma unroll
    for (int qt = 0; qt < 2; ++qt)
#pragma unroll
        for (int dt = 0; dt < 8; ++dt) O[qt][dt] = (f32x4){0.f, 0.f, 0.f, 0.f};
    const int nt = MOBA ? 4 * (blk + 1) : 4 * (q0 / 256 + 1);
    u32x4 kreg[NKL], vreg[2];
#define AT_KB(it) (MOBA ? ((it) < 4 ? blk * 256 + 64 * (it) : (((it) >> 2) - 1) * 256 + 64 * ((it) & 3)) : 64 * (it))
    unsigned koff[NKL], voff2[2];
#pragma unroll
    for (int _i = 0; _i < NKL; ++_i) { const int _c = tid + 512 * _i; koff[_i] = (unsigned)(((_c / KCH) * ld + kcol + 8 * (_c % KCH)) * 2); }
#pragma unroll
    for (int _i = 0; _i < 2; ++_i) { const int _c = tid + 512 * _i; voff2[_i] = (unsigned)((((_c >> 4)) * ld + vcol + 8 * (_c & 15)) * 2); }
#define AT_GLOAD(it) do { const char* _tb = (const char*)Pb + (size_t)AT_KB(it) * ld * 2; \
        _Pragma("unroll") for (int _i = 0; _i < NKL; ++_i) kreg[_i] = *(const u32x4*)(_tb + koff[_i]); \
        _Pragma("unroll") for (int _i = 0; _i < 2; ++_i) vreg[_i] = *(const u32x4*)(_tb + voff2[_i]); } while (0)
#define AT_LWRITE(bo) do { \
        _Pragma("unroll") for (int _i = 0; _i < NKL; ++_i) { const int _c = tid + 512 * _i; *(LAS u32x4*)(lds + (bo) + AT_KS + (_c / KCH) * PK + 16 * (_c % KCH)) = kreg[_i]; } \
        _Pragma("unroll") for (int _i = 0; _i < 2; ++_i) { const int _c = tid + 512 * _i; *(LAS u32x4*)(lds + (bo) + AT_VS + (_c >> 4) * AT_VP + 16 * (_c & 15)) = vreg[_i]; } } while (0)

    unsigned sel[2] = {0u, 0u};
    __syncthreads();
    if (MOBA) {
        const int h = tid >> 8, c = tid & 255; const bf16_t* src = h ? kml : kmh;
        *(LAS u32x4*)(lds + (h ? AT_KML : AT_KMH) + (c >> 4) * 272 + 16 * (c & 15)) = *(const u32x4*)(src + (c >> 4) * 128 + 8 * (c & 15));
    }
    AT_GLOAD(0);
    {
        u32x4 kreg2[NKL], vreg2[2];
        const char* _tb1 = (const char*)Pb + (size_t)AT_KB(nt > 1 ? 1 : 0) * ld * 2;
#pragma unroll
        for (int _i = 0; _i < NKL; ++_i) kreg2[_i] = *(const u32x4*)(_tb1 + koff[_i]);
#pragma unroll
        for (int _i = 0; _i < 2; ++_i) vreg2[_i] = *(const u32x4*)(_tb1 + voff2[_i]);
        AT_LWRITE(0);
#pragma unroll
        for (int _i = 0; _i < NKL; ++_i) kreg[_i] = kreg2[_i];
#pragma unroll
        for (int _i = 0; _i < 2; ++_i) vreg[_i] = vreg2[_i];
    }
    __syncthreads();
    if (MOBA) {
        if (blk <= 3) { sel[0] = sel[1] = (1u << blk) - 1u; }
        else {
#pragma unroll
            for (int qt = 0; qt < 2; ++qt) {
                f32x4 G = (f32x4){0.f, 0.f, 0.f, 0.f};
#pragma unroll
                for (int ks = 0; ks < NKS; ++ks) {
                    const bf16x8 ah = *(const LAS bf16x8*)(lds + AT_KMH + l15 * 272 + (32 * ks + 8 * quad) * 2);
                    const bf16x8 al = *(const LAS bf16x8*)(lds + AT_KML + l15 * 272 + (32 * ks + 8 * quad) * 2);
                    G = __builtin_amdgcn_mfma_f32_16x16x32_bf16(ah, Qf[qt][ks], G, 0, 0, 0);
                    G = __builtin_amdgcn_mfma_f32_16x16x32_bf16(al, Qf[qt][ks], G, 0, 0, 0);
                }
                float g16[16];
#pragma unroll
                for (int qq = 0; qq < 4; ++qq)
#pragma unroll
                    for (int j = 0; j < 4; ++j) g16[4 * qq + j] = __shfl(G[j], l15 + 16 * qq);
                unsigned taken = 0u, sb = 0u;
#pragma unroll
                for (int r = 0; r < 3; ++r) {
                    float best = -3e38f; int bi = 0;
#pragma unroll
                    for (int jj = 0; jj < 16; ++jj) { const float v = (jj < blk) ? g16[jj] : -1e30f; if (!((taken >> jj) & 1u) && v > best) { best = v; bi = jj; } }
                    taken |= 1u << bi; if (bi < blk) sb |= 1u << bi;
                }
                sel[qt] = sb;
            }
        }
    }
    for (int it = 0; it < nt; ++it) {
        const int cur = (it & 1) * AT_BUF;
        if (it + 1 < nt) { AT_LWRITE(AT_BUF - cur); if (it + 2 < nt) AT_GLOAD(it + 2); }
        const int kb = AT_KB(it);
        bool causal = false, ok0 = true, ok1 = true, skip = false;
        if (!MOBA || it < 4) { skip = (kb > qw0 + 31); causal = (kb + 63 > qw0); }
        else { const int pb = (it >> 2) - 1; ok0 = (sel[0] >> pb) & 1u; ok1 = (sel[1] >> pb) & 1u; skip = !__any(ok0 || ok1); }
        if (!skip) {
            const int qrel = qw0 + l15 - kb;
            const float ni0 = ok0 ? -mu[0] : -1e30f, ni1 = ok1 ? -mu[1] : -1e30f;
            f32x4 S[4][2];
#pragma unroll
            for (int kt = 0; kt < 4; ++kt) { S[kt][0] = (f32x4){ni0, ni0, ni0, ni0}; S[kt][1] = (f32x4){ni1, ni1, ni1, ni1}; }
            const LAS unsigned char* kbase = lds + cur + AT_KS + l15 * PK + 16 * quad;
            const LAS unsigned char* vb = lds + cur + AT_VS + (4 * quad + (l15 >> 2)) * AT_VP + (4 * (l15 & 3)) * 2;
            bf16x8 kfA[NKS], kfB[NKS];
            constexpr int VG = (DQK == 64) ? 2 : 4, GPA = 8 / VG, NG = 2 * GPA;
            s16x4 vlo[2][VG], vhi[2][VG];
#define AT_KREAD(dst, kt) do { _Pragma("unroll") for (int ks = 0; ks < NKS; ++ks) dst[ks] = *(const LAS bf16x8*)(kbase + (16 * (kt)) * PK + 64 * ks); } while (0)
#define AT_KMMA(src, kt) do { _Pragma("unroll") for (int ks = 0; ks < NKS; ++ks) { \
                S[kt][0] = __builtin_amdgcn_mfma_f32_16x16x32_bf16(src[ks], Qf[0][ks], S[kt][0], 0, 0, 0); \
                S[kt][1] = __builtin_amdgcn_mfma_f32_16x16x32_bf16(src[ks], Qf[1][ks], S[kt][1], 0, 0, 0); } } while (0)
#define AT_VREAD(g, bf) do { _Pragma("unroll") for (int d = 0; d < VG; ++d) { \
                vlo[bf][d] = vtr(vb + (32 * ((g) / GPA)) * AT_VP + 32 * (VG * ((g) % GPA) + d)); vhi[bf][d] = vtr(vb + (32 * ((g) / GPA) + 16) * AT_VP + 32 * (VG * ((g) % GPA) + d)); } } while (0)
#define AT_SB() __builtin_amdgcn_sched_barrier(0)
            AT_KREAD(kfA, 0); AT_KREAD(kfB, 1); AT_SB();
            AT_KMMA(kfA, 0); AT_KREAD(kfA, 2); AT_SB();
            AT_KMMA(kfB, 1); AT_KREAD(kfB, 3); AT_SB();
            AT_KMMA(kfA, 2); AT_VREAD(0, 0); AT_SB();
            AT_KMMA(kfB, 3); AT_SB();
            if (causal) {
#pragma unroll
                for (int qt = 0; qt < 2; ++qt)
#pragma unroll
                    for (int kt = 0; kt < 4; ++kt)
#pragma unroll
                        for (int j = 0; j < 4; ++j) if (16 * kt + 4 * quad + j > qrel + 16 * qt) S[kt][qt][j] = -1e30f;
            }
            if (it == 0) {
#pragma unroll
                for (int qt = 0; qt < 2; ++qt) {
                    float a = fmaxf(fmaxf(S[0][qt][0], S[0][qt][1]), fmaxf(S[0][qt][2], S[0][qt][3]));
#pragma unroll
                    for (int kt = 1; kt < 4; ++kt) a = fmaxf(a, fmaxf(fmaxf(S[kt][qt][0], S[kt][qt][1]), fmaxf(S[kt][qt][2], S[kt][qt][3])));
                    a = fmaxf(a, shx(a, 16, lane)); a = fmaxf(a, shx(a, 32, lane));
                    const float delta = fmaxf(a, -100.f);
                    mu[qt] += delta;
#pragma unroll
                    for (int kt = 0; kt < 4; ++kt) S[kt][qt] = S[kt][qt] - delta;
                }
            }
            bf16x8 Pf[2][2];
#pragma unroll
            for (int qt = 0; qt < 2; ++qt) {
                float rs = 0.f;
#pragma unroll
                for (int kt = 0; kt < 4; ++kt)
#pragma unroll
                    for (int j = 0; j < 4; ++j) { const float p = __builtin_amdgcn_exp2f(S[kt][qt][j]); S[kt][qt][j] = p; rs += p; }
                l[qt] += rs;
#pragma unroll
                for (int a = 0; a < 2; ++a) {
                    u32x4 w; w.x = cvtpk(S[2 * a][qt][0], S[2 * a][qt][1]); w.y = cvtpk(S[2 * a][qt][2], S[2 * a][qt][3]);
                    w.z = cvtpk(S[2 * a + 1][qt][0], S[2 * a + 1][qt][1]); w.w = cvtpk(S[2 * a + 1][qt][2], S[2 * a + 1][qt][3]);
                    Pf[qt][a] = __builtin_bit_cast(bf16x8, w);
                }
            }
            AT_SB();
#pragma unroll
            for (int g = 0; g < NG; ++g) {
                if (g < NG - 1) AT_VREAD(g + 1, (g + 1) & 1);
                AT_SB();
#pragma unroll
                for (int d = 0; d < VG; ++d) {
                    const s16x4 lo = vlo[g & 1][d], hi = vhi[g & 1][d];
                    const bf16x8 vf = (bf16x8){lo[0], lo[1], lo[2], lo[3], hi[0], hi[1], hi[2], hi[3]};
                    const int dt = VG * (g % GPA) + d;
                    O[0][dt] = __builtin_amdgcn_mfma_f32_16x16x32_bf16(vf, Pf[0][g / GPA], O[0][dt], 0, 0, 0);
                    O[1][dt] = __builtin_amdgcn_mfma_f32_16x16x32_bf16(vf, Pf[1][g / GPA], O[1][dt], 0, 0, 0);
                }
                AT_SB();
            }
            if (it > 0) {
                typedef unsigned short us2 __attribute__((ext_vector_type(2)));
                unsigned m16[2];
#pragma unroll
                for (int qt = 0; qt < 2; ++qt) {
                    const u32x4 pa = __builtin_bit_cast(u32x4, Pf[qt][0]), pb = __builtin_bit_cast(u32x4, Pf[qt][1]);
                    us2 m = __builtin_elementwise_max(__builtin_bit_cast(us2, pa.x), __builtin_bit_cast(us2, pa.y));
                    m = __builtin_elementwise_max(m, __builtin_elementwise_max(__builtin_bit_cast(us2, pa.z), __builtin_bit_cast(us2, pa.w)));
                    m = __builtin_elementwise_max(m, __builtin_elementwise_max(__builtin_bit_cast(us2, pb.x), __builtin_bit_cast(us2, pb.y)));
                    m = __builtin_elementwise_max(m, __builtin_elementwise_max(__builtin_bit_cast(us2, pb.z), __builtin_bit_cast(us2, pb.w)));
                    m16[qt] = m.x > m.y ? (unsigned)m.x : (unsigned)m.y;
                }
                if (__any(m16[0] > 0x4380u || m16[1] > 0x4380u)) {
#pragma unroll
                    for (int qt = 0; qt < 2; ++qt) {
                        float pm = __builtin_bit_cast(float, m16[qt] << 16);
                        pm = fmaxf(pm, shx(pm, 16, lane)); pm = fmaxf(pm, shx(pm, 32, lane));
                        const float delta = fmaxf(__builtin_amdgcn_logf(fmaxf(pm, 1.f)), 0.f), alpha = __builtin_amdgcn_exp2f(-delta);
                        mu[qt] += delta; l[qt] *= alpha;
#pragma unroll
                        for (int dt = 0; dt < 8; ++dt) O[qt][dt] = O[qt][dt] * alpha;
                    }
                }
            }
#undef AT_KREAD
#undef AT_KMMA
#undef AT_VREAD
#undef AT_SB
        }
        __syncthreads();
    }
#pragma unroll
    for (int qt = 0; qt < 2; ++qt) { float t = l[qt]; t += shx(t, 16, lane); t += shx(t, 32, lane); linv[qt] = 1.f / t; }
#undef AT_GLOAD
#undef AT_LWRITE
#undef AT_KB
}

__constant__ unsigned char UNIT_TAB[96] = {124, 34, 26, 123, 53, 10, 104, 45, 44, 107, 59, 20, 122, 50, 19, 109, 60, 24, 120, 57, 2, 108, 43, 37, 100, 61, 33, 116, 41, 35, 115, 75, 5, 121, 69, 0, 101, 48, 36, 112, 74, 1, 98, 52, 40, 99, 81, 11, 114, 49, 29, 105, 64, 8, 113, 58, 12, 106, 76, 4, 92, 68, 32, 117, 51, 18, 125, 67, 3, 97, 56, 27, 88, 72, 28, 77, 65, 42, 89, 66, 25, 91, 83, 16, 90, 82, 9, 93, 85, 13, 80, 84, 17, 96, 73, 21};
__device__ __forceinline__ bool deal_unit(int r, int G, int w, int& bh, int& qb) {
    if (G == 256) { if (r >= 3) return false; const unsigned e = UNIT_TAB[(w >> 3) * 3 + r]; qb = (int)(e >> 3); bh = (int)(e & 7u) * 8 + (w & 7); return true; }
    const int u = r * G + ((r & 1) ? (G - 1 - w) : w);
    if (u >= 768) return false;
    qb = 15 - u / 48; bh = u % 48; return true;
}

#define XB_TMO      128
#define XB_XCNT(j)  (256  + 64 * (j))
#define XB_XSUB(j)  (1280 + 64 * (j))
#define XB_XGEN(j)  (2304 + 64 * (j))
#define XB_TOP      3328
#define XB_TOPGEN   3392
#define XCD_BAR_WORDS 3456
#define XB_SPIN_CAP (1u << 22)
__device__ __forceinline__ unsigned xb_ld(unsigned* p)              { return __hip_atomic_load(p, __ATOMIC_RELAXED, __HIP_MEMORY_SCOPE_AGENT); }
__device__ __forceinline__ unsigned xb_add(unsigned* p, unsigned v) { return __hip_atomic_fetch_add(p, v, __ATOMIC_RELAXED, __HIP_MEMORY_SCOPE_AGENT); }
__device__ __forceinline__ unsigned xb_xcc_id() { return (unsigned)__builtin_amdgcn_s_getreg((3 << 11) | 20) & 0xFu; }
#define XB_SPIN(cond, bar) do { unsigned _sp = 0; while (cond) { __builtin_amdgcn_s_sleep(1); \
    if ((++_sp & 255u) == 0u) { if (xb_ld(&(bar)[XB_TMO])) break; if (_sp > XB_SPIN_CAP) { atomicAdd(&(bar)[XB_TMO], 1u); break; } } } } while (0)
struct XcdBarrier { unsigned* bar; unsigned x; volatile LAS unsigned* st; };
__device__ __forceinline__ XcdBarrier xcd_barrier_post(unsigned* bar, volatile LAS unsigned* st, int tid) {
    XcdBarrier b; b.bar = bar; b.x = xb_xcc_id(); b.st = st;
    if (tid == 0) (void)xb_add(&bar[XB_XCNT(b.x)], 1u);
    return b;
}
__device__ __forceinline__ void xcd_barrier_complete(unsigned* bar, unsigned x, unsigned& nloc, unsigned& nx) {
    const unsigned G = gridDim.x * gridDim.y * gridDim.z;
    unsigned sum, cnt, mine, sp = 0u;
    for (;;) {
        sum = 0u; cnt = 0u; mine = 0u;
#pragma unroll
        for (unsigned j = 0; j < 16; ++j) { const unsigned c = xb_ld(&bar[XB_XCNT(j)]); sum += c; cnt += (c > 0u) ? 1u : 0u; mine = (j == x) ? c : mine; }
        if (sum == G) break;
        __builtin_amdgcn_s_sleep(1);
        if ((++sp & 255u) == 0u) { if (xb_ld(&bar[XB_TMO])) break; if (sp > XB_SPIN_CAP) { atomicAdd(&bar[XB_TMO], 1u); break; } }
    }
    nloc = mine > 0u ? mine : 1u; nx = cnt > 0u ? cnt : 1u;
}
__device__ __forceinline__ void xcd_barrier(const XcdBarrier& b, int tid) {
    asm volatile("s_waitcnt vmcnt(0)" ::: "memory");
    __syncthreads();
    if (tid == 0) {
        unsigned* bar = b.bar;
        __builtin_amdgcn_s_waitcnt(0);
        unsigned nloc = b.st[0], nx = b.st[1];
        if (nloc == 0u) { xcd_barrier_complete(bar, b.x, nloc, nx); b.st[0] = nloc; b.st[1] = nx; }
        const unsigned old = xb_add(&bar[XB_XSUB(b.x)], 1u);
        const unsigned gen = old / nloc;
        if (old + 1u == (gen + 1u) * nloc) {
            __builtin_amdgcn_fence(__ATOMIC_RELEASE, "agent");
            asm volatile("s_waitcnt vmcnt(0)" ::: "memory");
            const unsigned og = xb_add(&bar[XB_TOP], 1u);
            const unsigned tg = og / nx;
            if (og + 1u == (tg + 1u) * nx) xb_add(&bar[XB_TOPGEN], 1u);
            else XB_SPIN(xb_ld(&bar[XB_TOPGEN]) == tg, bar);
            __builtin_amdgcn_fence(__ATOMIC_ACQUIRE, "agent");
            xb_add(&bar[XB_XGEN(b.x)], 1u);
            asm volatile("s_waitcnt vmcnt(0)" ::: "memory");
        } else {
            XB_SPIN(xb_ld(&bar[XB_XGEN(b.x)]) == gen, bar);
            __builtin_amdgcn_fence(__ATOMIC_ACQUIRE, "agent");
            asm volatile("s_waitcnt vmcnt(0)" ::: "memory");
        }
    }
    __syncthreads();
}

struct Args { const float* in[19]; float* out; unsigned char* ws; int ph_lo, ph_hi; };
constexpr int N_PHASES = 2 + 6 * DEPTH;

__global__ void __launch_bounds__(NTHR, 2) mega_fwd(Args args) {
    extern __shared__ __attribute__((aligned(16))) unsigned char lds_raw[];
    LAS unsigned char* lds = (LAS unsigned char*)lds_raw;
    const int G0 = gridDim.x, wg0 = blockIdx.x, wave0 = __builtin_amdgcn_readfirstlane(threadIdx.x >> 6);
    unsigned char* ws = args.ws;
    float* ss = (float*)(ws + WS_SS);
    bf16_t* hbf = (bf16_t*)(ws + WS_HBF);
    bf16_t* mix = (bf16_t*)(ws + WS_MIX);
    bf16_t* proj = (bf16_t*)(ws + WS_PROJ);
    bf16_t* kmh = (bf16_t*)(ws + WS_KMH);
    bf16_t* kml = (bf16_t*)(ws + WS_KML);
    float* out = args.out;

    volatile LAS unsigned* bst = (volatile LAS unsigned*)(lds + LDS_BYTES - 64);
    volatile LAS unsigned* ptab = (volatile LAS unsigned*)(lds + LDS_BYTES - 256);
    if (threadIdx.x < 2) bst[threadIdx.x] = 0u;
    if (threadIdx.x < 19) { const unsigned long long p = (unsigned long long)args.in[threadIdx.x]; ptab[2 * threadIdx.x] = (unsigned)p; ptab[2 * threadIdx.x + 1] = (unsigned)(p >> 32); }
    __syncthreads();
#define INP(i) ((const float*)(((unsigned long long)(unsigned)__builtin_amdgcn_readfirstlane(ptab[2 * (i) + 1]) << 32) | (unsigned long long)(unsigned)__builtin_amdgcn_readfirstlane(ptab[2 * (i)])))
    XcdBarrier bar = xcd_barrier_post((unsigned*)(ws + WS_BAR), bst, (int)threadIdx.x);
    int rep = 0;
    for (int ph = args.ph_lo; ph < args.ph_hi; ++ph) {
        int tid; asm volatile("v_mbcnt_lo_u32_b32 %0, -1, 0\n\tv_mbcnt_hi_u32_b32 %0, -1, %0" : "=v"(tid)); tid += wave0 * 64;
        int G = G0; asm volatile("" : "+s"(G));
        int wg = wg0; asm volatile("" : "+s"(wg));
        const int lane = tid & 63, wave = __builtin_amdgcn_readfirstlane(tid >> 6), gw = wg * NWAVES + wave, NGW = G * NWAVES;
        const int L = (ph - 1) / 6, k = (ph - 1) % 6, j = L >> 1; const bool AB = !(L & 1);
        unsigned char* wl = ws + WS_W + (size_t)L * WS_WL;
        bool did = true;
        if (ph == 0) {
            LAS float* scr = (LAS float*)(lds + wave * 17408);
            LAS float* scr2 = scr + 64 * 33;
            constexpr int I_AB = 16 * (AB_IN / 32) + 512 + 3 * 1408, I_CD = 16 * (CD_IN / 32) + 512 + 3 * 1408, I_ALL = 2 * (I_AB + I_CD);
            for (int it = gw; it < I_ALL; it += NGW) {
                int r = it, l2 = 0;
                if (r >= I_AB) { r -= I_AB; l2 = 1; if (r >= I_CD) { r -= I_CD; l2 = 2; if (r >= I_AB) { r -= I_AB; l2 = 3; } } }
                const int jj = l2 >> 1; const bool ab = !(l2 & 1);
                unsigned char* wll = ws + WS_W + (size_t)l2 * WS_WL;
                const int NIN = ab ? AB_IN : CD_IN, I_IN = 16 * (NIN / 32);
                if (r < I_IN) {
                    const float* W = ab ? INP(4) + (size_t)jj * D * AB_IN : INP(10) + (size_t)jj * D * CD_IN;
                    const int nblk = NIN / 32, kb = r / nblk, nb = r % nblk;
                    const int n0 = 32 * nb;
                    const float cs = ab ? ((n0 >= 256 && n0 < 1024) ? 0.125f * 1.4426950408889634f : 1.f) : ((n0 >= 512 && n0 < 1280) ? 0.08838834764831845f * 1.4426950408889634f : 1.f);
                    tile_load(W, NIN, INP(1) + l2 * D, 64 * kb, 32 * nb, scr, lane, cs);
                    tile_store_t(scr, (bf16_t*)(wll + WO_IN), D, 64 * kb, 32 * nb, 0, lane);
                    continue;
                }
                r -= I_IN;
                if (r < 512) {
                    const float* W = (ab ? INP(5) : INP(11)) + (size_t)jj * D * D;
                    const int kb = r / 32, nb = r % 32;
                    if (ab && kb < 4) {
                        tile_load(W, D, INP(7) + jj * 256, 64 * kb, 32 * nb, scr, lane);
                        const float* pw = INP(6) + ((size_t)jj * 4 + kb) * 64 * 64;
                        const int nn = lane & 31, ch = lane >> 5;
                        for (int c = 0; c < 32; ++c) {
                            const f32x4* pr = (const f32x4*)(pw + (ch * 32 + c) * 64); float a = 0.f;
#pragma unroll
                            for (int d4 = 0; d4 < 16; ++d4) { const f32x4 p = pr[d4];
                                a += p[0] * scr[(4 * d4) * 33 + nn] + p[1] * scr[(4 * d4 + 1) * 33 + nn] + p[2] * scr[(4 * d4 + 2) * 33 + nn] + p[3] * scr[(4 * d4 + 3) * 33 + nn]; }
                            scr2[(ch * 32 + c) * 33 + nn] = a;
                        }
                        asm volatile("s_waitcnt lgkmcnt(0)" ::: "memory");
                        tile_store_t(scr2, (bf16_t*)(wll + WO_OUT), D, 64 * kb, 32 * nb, 0, lane);
                    } else {
                        tile_load(W, D, nullptr, 64 * kb, 32 * nb, scr, lane);
                        tile_store_t(scr, (bf16_t*)(wll + WO_OUT), D, 64 * kb, 32 * nb, 0, lane);
                    }
                    continue;
                }
                r -= 512;
                if (r < 2 * 1408) {
                    const int up = r >= 1408; if (up) r -= 1408;
                    const float* W = (up ? INP(17) : INP(16)) + (size_t)l2 * D * DFF;
                    const int kb = r / 88, nb = r % 88;
                    tile_load(W, DFF, INP(2) + l2 * D, 64 * kb, 32 * nb, scr, lane);
                    tile_store_t(scr, (bf16_t*)(wll + WO_GU), D, 64 * kb, 32 * nb, up ? 2 : 1, lane);
                    continue;
                }
                r -= 2 * 1408;
                {
                    const float* W = INP(18) + (size_t)l2 * DFF * D;
                    const int kb = r / 32, nb = r % 32;
                    tile_load(W, D, nullptr, 64 * kb, 32 * nb, scr, lane);
                    tile_store_t(scr, (bf16_t*)(wll + WO_D), DFF, 64 * kb, 32 * nb, 0, lane);
                }
            }
            const float* xin = INP(0);
            for (int m0 = gw; m0 < M; m0 += 4 * NGW) {
                f32x4 v[4][4];
#pragma unroll
                for (int rr2 = 0; rr2 < 4; ++rr2) { const int m = (m0 + rr2 * NGW < M) ? m0 + rr2 * NGW : m0; const f32x4* xr = (const f32x4*)(xin + (size_t)m * D) + lane;
#pragma unroll
                    for (int q = 0; q < 4; ++q) v[rr2][q] = xr[64 * q]; }
#pragma unroll
                for (int rr2 = 0; rr2 < 4; ++rr2) { const int m = m0 + rr2 * NGW; if (m < M) {
                    float sm = 0.f;
#pragma unroll
                    for (int q = 0; q < 4; ++q) sm += v[rr2][q][0] * v[rr2][q][0] + v[rr2][q][1] * v[rr2][q][1] + v[rr2][q][2] * v[rr2][q][2] + v[rr2][q][3] * v[rr2][q][3];
                    const float s = wave_sum(sm, lane); if (lane < 4) ((f32x4*)(ss + (size_t)m * 16))[lane] = (f32x4){lane == 0 ? s : 0.f, 0.f, 0.f, 0.f};
                    u32x2* o = (u32x2*)(hbf + (size_t)m * D) + lane;
#pragma unroll
                    for (int q = 0; q < 4; ++q) { u32x2 w; w.x = cvtpk(v[rr2][q][0], v[rr2][q][1]); w.y = cvtpk(v[rr2][q][2], v[rr2][q][3]); o[64 * q] = w; } } }
            }
        } else if (ph == N_PHASES - 1) {
            const float* gf = INP(3); const float* s8 = ss + (size_t)8 * M * 16;
            for (int m0 = gw; m0 < M; m0 += 4 * NGW) {
                u32x2 hv[4][4]; float r4[4];
#pragma unroll
                for (int rr2 = 0; rr2 < 4; ++rr2) { const int m = (m0 + rr2 * NGW < M) ? m0 + rr2 * NGW : m0; r4[rr2] = row_rstd(s8, m);
                    const u32x2* hr = (const u32x2*)(hbf + (size_t)m * D) + lane;
#pragma unroll
                    for (int q = 0; q < 4; ++q) hv[rr2][q] = hr[64 * q]; }
#pragma unroll
                for (int rr2 = 0; rr2 < 4; ++rr2) { const int m = m0 + rr2 * NGW; if (m < M) {
                    f32x4* orow = (f32x4*)(out + (size_t)m * D) + lane;
#pragma unroll
                    for (int q = 0; q < 4; ++q) { const f32x4 g4 = ((const f32x4*)gf)[lane + 64 * q]; const u32x2 h2 = hv[rr2][q];
                        orow[64 * q] = (f32x4){bflo(h2.x), bfhi(h2.x), bflo(h2.y), bfhi(h2.y)} * r4[rr2] * g4; } } }
            }
        } else if (k == 0) {
            const int NIN = AB ? AB_IN : CD_IN;
            pg8::Gemm g{hbf, (const bf16_t*)(wl + WO_IN), M, NIN, D}; pg8::StaticOrder S; S.init(M, NIN, G, wg);
            pg8::EpiProj E{proj, NIN, ss + (size_t)(2 * L) * M * 16};
#ifndef X_NO_PROJ
            pg8::gemm_phase<pg8::EpiProj, D>(tid, lds, g, S, E);
#endif
        } else if (k == 1 && AB) {
#pragma unroll 1
            for (int rr = 0; rr < ((X_SUB & 1) ? 2 : 1); ++rr)
            for (int tok0 = 8 * gw; tok0 < M; tok0 += 8 * NGW) {
                const int t0 = tok0 & (SEQ - 1), w = 2 << (lane >> 4);
                const bf16_t* base = proj + (size_t)tok0 * AB_IN + 4 * lane;
                u32x2 v[23];
#pragma unroll
                for (int r = 0; r < 23; ++r) { const int d = r - 15; v[r] = *(const u32x2*)(base + (ptrdiff_t)((t0 + d >= 0) ? d : -t0) * AB_IN); }
#pragma unroll
                for (int i = 0; i < 8; ++i) {
                    const int cnt = (t0 + i + 1 < w) ? t0 + i + 1 : w;
                    const float c0 = bflo(v[15 + i].x), c1 = bfhi(v[15 + i].x), c2_ = bflo(v[15 + i].y), c3 = bfhi(v[15 + i].y);
                    float s0 = c0, s1 = c1, s2 = c2_, s3 = c3;
#pragma unroll
                    for (int q = 1; q < 16; ++q) { const float wq = (q < cnt) ? 1.f : 0.f; const u32x2 u = v[15 + i - q]; s0 += wq * bflo(u.x); s1 += wq * bfhi(u.x); s2 += wq * bflo(u.y); s3 += wq * bfhi(u.y); }
                    const float inv = 1.f / (float)cnt;
                    u32x2 o; o.x = cvtpk(s0 * inv - c0, s1 * inv - c1); o.y = cvtpk(s2 * inv - c2_, s3 * inv - c3);
                    *(u32x2*)(mix + (size_t)(tok0 + i) * D + 4 * lane) = o;
                }
            }
#ifndef X_NO_DIFF
            const float* lp = INP(8) + (size_t)j * 4 * 64;
            const float lam_init = (L == 0) ? 0.2f : 0.47071301834358416f;
            const float lam = __expf(wave_sum(lp[lane] * lp[64 + lane], lane)) - __expf(wave_sum(lp[128 + lane] * lp[192 + lane], lane)) + lam_init;
            const float* sg = INP(9) + (size_t)j * 128;
#pragma unroll 1
            for (int rr = 0; rr < ((X_SUB & 2) ? 2 : 1); ++rr)
            for (int r = 0;; ++r) {
                int bh, qb; if (!deal_unit(r, G, wg, bh, qb)) break;
                const int b = bh / 6, h = bh % 6;
                const bf16_t* Pb = proj + (size_t)b * SEQ * AB_IN;
#pragma unroll 1
                for (int map = 0; map < 2; ++map) {
                    int tu = tid; asm volatile("" : "+v"(tu));
                    const int l15 = tu & 15, quad = (tu & 63) >> 4;
                    f32x4* o1s = (f32x4*)(ws + WS_O1) + (size_t)wg * 16 * NTHR + tu;
                    f32x4 O[2][8]; float li[2];
                    attn_pass<64, false>(tu, lds, Pb, AB_IN, 256 + (2 * h + map) * 64, 1024 + (2 * h + map) * 64, 1792 + h * 128, qb * 256, 0, nullptr, nullptr, O, li);
                    if (map == 0) {
#pragma unroll
                        for (int qt = 0; qt < 2; ++qt)
#pragma unroll
                            for (int dt = 0; dt < 8; ++dt) o1s[(qt * 8 + dt) * NTHR] = O[qt][dt] * li[qt];
                    } else {
#pragma unroll
                        for (int qt = 0; qt < 2; ++qt) {
                            float sq = 0.f; const float f = lam * li[qt];
#pragma unroll
                            for (int dt = 0; dt < 8; ++dt) { O[qt][dt] = o1s[(qt * 8 + dt) * NTHR] - O[qt][dt] * f; const f32x4 v = O[qt][dt]; sq += v[0] * v[0] + v[1] * v[1] + v[2] * v[2] + v[3] * v[3]; }
                            sq += shx(sq, 16, tu & 63); sq += shx(sq, 32, tu & 63);
                            const float rn = __builtin_amdgcn_rsqf(sq * (1.f / 128.f) + EPS) * (1.f - lam_init);
                            const float* sgp = sg; asm volatile("" : "+s"(sgp));
                            bf16_t* orow = mix + (size_t)(b * SEQ + qb * 256 + 32 * wave + 16 * qt + l15) * D + 256 + h * 128 + 4 * quad;
#pragma unroll
                            for (int dt = 0; dt < 8; ++dt) { const f32x4 g4 = *(const f32x4*)(sgp + 16 * dt + 4 * quad); const f32x4 v = O[qt][dt] * rn * g4;
                                u32x2 w; w.x = cvtpk(v[0], v[1]); w.y = cvtpk(v[2], v[3]); *(u32x2*)(orow + 16 * dt) = w; }
                        }
                    }
                }
            }
#endif
        } else if (k == 1 && !AB) {
            LAS float* red = (LAS float*)lds;
#pragma unroll 1
            for (int rr = 0; rr < ((X_SUB & 4) ? 2 : 1); ++rr) {
            for (int it0 = wg; it0 < 768; it0 += 3 * G) {
                u32x4 kv[3][8];
                const int sub = lane >> 4, ch = lane & 15;
#pragma unroll
                for (int j3 = 0; j3 < 3; ++j3) {
                    const int it = (it0 + j3 * G < 768) ? it0 + j3 * G : it0;
                    const int b = it / 96, hh = (it / 16) % 6, blk = it & 15;
                    const bf16_t* kp = proj + (size_t)(b * SEQ + blk * 256 + 32 * wave + sub) * CD_IN + 1280 + hh * 128 + 8 * ch;
#pragma unroll
                    for (int r = 0; r < 8; ++r) kv[j3][r] = *(const u32x4*)(kp + (size_t)(4 * r) * CD_IN);
                }
#pragma unroll
                for (int j3 = 0; j3 < 3; ++j3) {
                    const int it = it0 + j3 * G;
                    float a[8] = {0.f, 0.f, 0.f, 0.f, 0.f, 0.f, 0.f, 0.f};
#pragma unroll
                    for (int r = 0; r < 8; ++r) { const u32x4 q = kv[j3][r];
                        a[0] += bflo(q.x); a[1] += bfhi(q.x); a[2] += bflo(q.y); a[3] += bfhi(q.y); a[4] += bflo(q.z); a[5] += bfhi(q.z); a[6] += bflo(q.w); a[7] += bfhi(q.w); }
#pragma unroll
                    for (int e = 0; e < 8; ++e) { a[e] += shx(a[e], 16, lane); a[e] += shx(a[e], 32, lane); }
                    __syncthreads();
                    if (sub == 0) {
#pragma unroll
                        for (int e = 0; e < 8; ++e) red[wave * 128 + 8 * ch + e] = a[e];
                    }
                    __syncthreads();
                    if (it < 768 && tid < 128) { float s = 0.f;
#pragma unroll
                        for (int w = 0; w < 8; ++w) s += red[w * 128 + tid];
                        s *= (1.f / 256.f);
                        const unsigned hi = cvtpk(s, 0.f) & 0xffffu; const float hf = __builtin_bit_cast(float, hi << 16);
                        const unsigned lo = cvtpk(s - hf, 0.f) & 0xffffu;
                        kmh[(size_t)it * 128 + tid] = (bf16_t)hi; kml[(size_t)it * 128 + tid] = (bf16_t)lo; }
                }
            }
            {
                LAS float* hp = (LAS float*)lds;
                LAS float* cw = (LAS float*)(lds + 94 * 1024);
                const float* convw = INP(12) + (size_t)j * 31 * 256;
                const float* convb = INP(13) + (size_t)j * 256; const float* lng = INP(14) + (size_t)j * 256; const float* lnb = INP(15) + (size_t)j * 256;
                for (int u = wg; u < 512; u += G) {
                    const int b = u >> 6, t0 = (u & 63) * 64;
                    __syncthreads();
                    for (int i = tid; i < 31 * 64; i += NTHR) ((LAS f32x4*)cw)[i] = ((const f32x4*)convw)[i];
                    {
                        const int c4 = tid & 63;
                        u32x2 av[12], gv[12];
#pragma unroll
                        for (int p = 0; p < 12; ++p) {
                            int r = 8 * p + (tid >> 6); r = r < 94 ? r : 93; int t = t0 - 30 + r; t = t > 0 ? t : 0;
                            const bf16_t* up = proj + (size_t)(b * SEQ + t) * CD_IN + 4 * c4;
                            av[p] = *(const u32x2*)up; gv[p] = *(const u32x2*)(up + 256);
                        }
#pragma unroll
                        for (int p = 0; p < 12; ++p) {
                            const int r = 8 * p + (tid >> 6), t = t0 - 30 + r;
                            if (r < 94) {
                                f32x4 hv = (f32x4){0.f, 0.f, 0.f, 0.f};
                                if (t >= 0) {
                                    const u32x2 a = av[p], gt = gv[p];
                                    hv[0] = bflo(a.x) * fast_sigmoid(bflo(gt.x)); hv[1] = bfhi(a.x) * fast_sigmoid(bfhi(gt.x));
                                    hv[2] = bflo(a.y) * fast_sigmoid(bflo(gt.y)); hv[3] = bfhi(a.y) * fast_sigmoid(bfhi(gt.y));
                                }
                                *(LAS f32x4*)(hp + r * 256 + 4 * c4) = hv;
                            }
                        }
                    }
                    __syncthreads();
                    const f32x4 bias = *(const f32x4*)(convb + 4 * lane), g4 = *(const f32x4*)(lng + 4 * lane), b4 = *(const f32x4*)(lnb + 4 * lane);
                    f32x4 a8[8];
#pragma unroll
                    for (int i = 0; i < 8; ++i) a8[i] = bias;
#pragma unroll 4
                    for (int q = 0; q < 31; ++q) {
                        const f32x4 wq = *(const LAS f32x4*)(cw + q * 256 + 4 * lane);
#pragma unroll
                        for (int i = 0; i < 8; ++i) a8[i] += wq * *(const LAS f32x4*)(hp + (8 * wave + i + q) * 256 + 4 * lane);
                    }
#pragma unroll
                    for (int i = 0; i < 8; ++i) {
                        const f32x4 a = a8[i];
                        const float mu = wave_sum(a[0] + a[1] + a[2] + a[3], lane) * (1.f / 256.f);
                        const f32x4 dlt = a - mu;
                        const float var = wave_sum(dlt[0] * dlt[0] + dlt[1] * dlt[1] + dlt[2] * dlt[2] + dlt[3] * dlt[3], lane) * (1.f / 256.f);
                        const float rs = __builtin_amdgcn_rsqf(var + EPS);
                        f32x4 y = dlt * rs * g4 + b4;
#pragma unroll
                        for (int q = 0; q < 4; ++q) y[q] = y[q] * fast_sigmoid(y[q]);
                        u32x2 o; o.x = cvtpk(y[0], y[1]); o.y = cvtpk(y[2], y[3]);
                        *(u32x2*)(mix + (size_t)(b * SEQ + t0 + 8 * wave + i) * D + 4 * lane) = o;
                    }
                }
            }
            __syncthreads();
            }
        } else if (k == 2) {
            if (AB) did = false;
            else {
#ifndef X_NO_MOBA
#pragma unroll 1
                for (int rr = 0; rr < ((X_SUB & 8) ? 2 : 1); ++rr)
                for (int r = 0;; ++r) {
                    int bh, qb; if (!deal_unit(r, G, wg, bh, qb)) break;
                    const int b = bh / 6, h = bh % 6;
                    const bf16_t* Pb = proj + (size_t)b * SEQ * CD_IN;
                    int tu = tid; asm volatile("" : "+v"(tu));
                    const int l15 = tu & 15, quad = (tu & 63) >> 4;
                    f32x4 O[2][8]; float li[2];
                    attn_pass<128, true>(tu, lds, Pb, CD_IN, 512 + h * 128, 1280 + h * 128, 2048 + h * 128, qb * 256, qb, kmh + (size_t)bh * 16 * 128, kml + (size_t)bh * 16 * 128, O, li);
#pragma unroll
                    for (int qt = 0; qt < 2; ++qt) {
                        bf16_t* orow = mix + (size_t)(b * SEQ + qb * 256 + 32 * wave + 16 * qt + l15) * D + 256 + h * 128 + 4 * quad;
#pragma unroll
                        for (int dt = 0; dt < 8; ++dt) { const f32x4 v = O[qt][dt] * li[qt]; u32x2 w; w.x = cvtpk(v[0], v[1]); w.y = cvtpk(v[2], v[3]); *(u32x2*)(orow + 16 * dt) = w; }
                    }
                }
#endif
            }
        } else if (k == 3 || k == 5) {
            const bool dn = (k == 5);
            pg8::Gemm g{dn ? proj : mix, (const bf16_t*)(wl + (dn ? WO_D : WO_OUT)), M, D, dn ? DFF : D}; pg8::StaticOrder S; S.init(M, D, G, wg);
            pg8::EpiRes E{hbf, ss + (size_t)(2 * L + (dn ? 2 : 1)) * M * 16};
#ifndef X_NO_RES
            if (dn) pg8::gemm_phase<pg8::EpiRes, DFF>(tid, lds, g, S, E); else pg8::gemm_phase<pg8::EpiRes, D>(tid, lds, g, S, E);
#endif
        } else {
            pg8::Gemm g{hbf, (const bf16_t*)(wl + WO_GU), M, 2 * DFF, D}; pg8::StaticOrder S; S.init(M, 2 * DFF, G, wg);
            pg8::EpiGlu E{proj, ss + (size_t)(2 * L + 1) * M * 16};
#ifndef X_NO_GLU
            pg8::gemm_phase<pg8::EpiGlu, D>(tid, lds, g, S, E);
#endif
        }
        if (X_REP && X_REP < 256 && did && ph >= 1 && ph < N_PHASES - 1 && ((X_REP >> k) & 1) && rep == 0) { rep = 1; xcd_barrier(bar, tid); --ph; continue; }
        rep = 0;
        if (did && ph + 1 < args.ph_hi) {
            if (args.ph_lo == 0x7fffffff) cg::this_grid().sync();
            xcd_barrier(bar, tid);
        }
    }
}

extern "C" void kernel_launch(void* const* d_in, const int* in_sizes, int n_in, void* d_out, int out_size, void* d_ws, size_t ws_size, hipStream_t stream) {
    static int grid = 0;
    if (grid == 0) {
        if (n_in != 19 || in_sizes[0] != M * D || out_size != M * D || ws_size < WS_END) { fprintf(stderr, "kernel_launch: unexpected shapes (n_in %d, in0 %d, out %d, ws %zu)\n", n_in, n_in > 0 ? in_sizes[0] : -1, out_size, ws_size); grid = -1; return; }
        int dev = 0, cus = 0, per_cu = 0;
        hipGetDevice(&dev); hipDeviceGetAttribute(&cus, hipDeviceAttributeMultiprocessorCount, dev);
        if (hipFuncSetAttribute((const void*)mega_fwd, hipFuncAttributeMaxDynamicSharedMemorySize, LDS_BYTES) != hipSuccess) { fprintf(stderr, "kernel_launch: hipFuncSetAttribute failed\n"); grid = -1; return; }
        if (hipOccupancyMaxActiveBlocksPerMultiprocessor(&per_cu, (const void*)mega_fwd, NTHR, LDS_BYTES) != hipSuccess || per_cu < 1) { fprintf(stderr, "kernel_launch: occupancy query gave %d\n", per_cu); per_cu = 1; }
        (void)hipGetLastError();
        grid = cus * (per_cu > 1 ? 1 : per_cu);
        if (grid <= 0 || grid > 256) grid = 256;
    }
    if (grid < 0) return;
    Args a{};
    for (int i = 0; i < 19; ++i) a.in[i] = (const float*)d_in[i];
    a.out = (float*)d_out; a.ws = (unsigned char*)d_ws;
#if MK_MULTI
    for (int ph = 0; ph < N_PHASES; ++ph) {
        if (ph >= 1 && ph < N_PHASES - 1 && ((ph - 1) % 6) == 2 && (((ph - 1) / 6) & 1) == 0) continue;
        a.ph_lo = ph; a.ph_hi = ph + 1;
        hipLaunchKernelGGL(mega_fwd, dim3(grid), dim3(NTHR), LDS_BYTES, stream, a);
    }
#else
    a.ph_lo = 0; a.ph_hi = N_PHASES;
    if (hipMemsetAsync((char*)d_ws + WS_BAR, 0, XCD_BAR_WORDS * 4, stream) != hipSuccess) { fprintf(stderr, "kernel_launch: hipMemsetAsync failed\n"); return; }
    void* kargs[] = {&a};
    hipError_t e = hipLaunchCooperativeKernel((const void*)mega_fwd, dim3(grid), dim3(NTHR), kargs, LDS_BYTES, stream);
    if (e != hipSuccess) fprintf(stderr, "kernel_launch: cooperative launch failed: %s (grid %d)\n", hipGetErrorString(e), grid);
#endif
}
```

```cpp
#include <hip/hip_runtime.h>
#include <hip/hip_cooperative_groups.h>
#include <cstdio>
#include <cstdint>
namespace cg = cooperative_groups;

#ifndef MK_MULTI
#define MK_MULTI 0
#endif

#ifndef X_SUB
#define X_SUB 0
#endif
#ifndef X_REP
#define X_REP 0
#endif

#define LAS __attribute__((address_space(3)))
typedef unsigned short bf16_t;
typedef short bf16x8 __attribute__((ext_vector_type(8)));
typedef short s16x4 __attribute__((ext_vector_type(4)));
typedef float f32x4 __attribute__((ext_vector_type(4)));
typedef float f32x2 __attribute__((ext_vector_type(2)));
typedef unsigned u32x4 __attribute__((ext_vector_type(4)));
typedef unsigned u32x2 __attribute__((ext_vector_type(2)));
typedef __bf16 bf16x2_t __attribute__((ext_vector_type(2)));

constexpr int D = 1024, BATCH = 8, SEQ = 4096, M = BATCH * SEQ, DEPTH = 4;
constexpr int AB_IN = 2560, CD_IN = 2816, DFF = 2816;
constexpr float EPS = 1e-6f;
constexpr int NWAVES = 8, NTHR = 512;
constexpr int LDS_BYTES = 147456;

constexpr size_t MiB = 1u << 20;
constexpr size_t WS_SS = 444 * MiB;
constexpr size_t WS_BAR = 0;
constexpr size_t WS_KMH = 2 * MiB, WS_KML = 2 * MiB + 256 * 1024;
constexpr size_t WS_W = 4 * MiB, WS_WL = 26 * MiB;
constexpr size_t WO_IN = 0, WO_OUT = 6 * MiB, WO_GU = 8 * MiB, WO_D = 19 * MiB;
constexpr size_t WS_HBF = 108 * MiB;
constexpr size_t WS_MIX = 172 * MiB;
constexpr size_t WS_PROJ = 236 * MiB;
constexpr size_t WS_O1 = 412 * MiB;
constexpr size_t WS_END = 462 * MiB;

__device__ __forceinline__ unsigned cvtpk(float lo, float hi) { f32x2 v = {lo, hi}; bf16x2_t b = __builtin_convertvector(v, bf16x2_t); return __builtin_bit_cast(unsigned, b); }
__device__ __forceinline__ float bflo(unsigned u) { return __builtin_bit_cast(float, u << 16); }
__device__ __forceinline__ float bfhi(unsigned u) { return __builtin_bit_cast(float, u & 0xffff0000u); }
__device__ __forceinline__ float shx(float v, int m, int lane) { return __builtin_bit_cast(float, __builtin_amdgcn_ds_bpermute((lane ^ m) << 2, __builtin_bit_cast(int, v))); }
__device__ __forceinline__ float wave_sum(float v, int lane) {
#pragma unroll
    for (int o = 1; o < 64; o <<= 1) v += shx(v, o, lane);
    return v;
}
__device__ __forceinline__ float fast_sigmoid(float x) { return __builtin_amdgcn_rcpf(1.f + __builtin_amdgcn_exp2f(-1.4426950408889634f * x)); }

__device__ __forceinline__ float row_rstd(const float* ss, int row) {
    const f32x4* p = (const f32x4*)(ss + (size_t)row * 16);
    const f32x4 a = p[0], b = p[1], c = p[2], d = p[3];
    const float s = ((a[0] + a[1]) + (a[2] + a[3])) + ((b[0] + b[1]) + (b[2] + b[3])) + (((c[0] + c[1]) + (c[2] + c[3])) + ((d[0] + d[1]) + (d[2] + d[3])));
    return __builtin_amdgcn_rsqf(s * (1.f / D) + EPS);
}

namespace pg8 {
constexpr int BM = 256, BK = 64, HALF = 128, HTB = HALF * BK * 2, NXCD = 8, WGM = 8;
__host__ __device__ __forceinline__ int lds_byte(int r, int c) { const int st = (r >> 4) * 2 + (c >> 5), rr = r & 15, cc = c & 31, ob = rr * 64 + cc * 2; return st * 1024 + (ob ^ (((ob >> 9) & 1) << 5)); }
__host__ __device__ __forceinline__ void stage_rc(int b, int& R, int& C) { const int st = b / 1024, sb = b % 1024, swz = sb ^ (((sb >> 9) & 1) << 5); R = (st >> 1) * 16 + swz / 64; C = (st & 1) * 32 + (swz % 64) / 2; }
__host__ __device__ __forceinline__ int perm32(int rho) { const int n = rho >> 4, i = rho & 15; return 8 * (i >> 2) + 4 * n + (i & 3); }

struct Unit { int pm, pn; };
struct Gemm { const bf16_t* A; const bf16_t* Bt; int M, N, K; };

struct StaticOrder {
    int nM, nN, nwg, G, c;
    __device__ void init(int M_, int N_, int G_, int c_) { nM = M_ / BM; nN = N_ / BM; nwg = nM * nN; G = G_; c = c_; }
    __device__ bool next(int i, Unit& u) const {
        const long L = (long)i * G + c; if (L >= nwg) return false;
        int wgid = (int)L; { const int q = nwg / NXCD, r = nwg % NXCD, xcd = wgid % NXCD, off = wgid / NXCD; wgid = (xcd < r ? xcd * (q + 1) : r * (q + 1) + (xcd - r) * q) + off; }
        const int nig = WGM * nN, gid = wgid / nig, fm = gid * WGM, gsz = (nM - fm) < WGM ? (nM - fm) : WGM;
        u.pm = fm + ((wgid % nig) % gsz); u.pn = (wgid % nig) / gsz; return true;
    }
};


struct EpiProj {
    static constexpr bool PRE = true;
    bf16_t* O; int ldc; const float* ss;
    __device__ __forceinline__ void operator()(const f32x4 (&acc)[2][2][4][2], const Unit& u, const LAS float* rt, int wr, int wc, int fr, int fq) const {
        const int row0 = u.pm * BM + wr * 64 + fr, col0 = u.pn * BM + wc * 32 + 8 * fq;
#pragma unroll
        for (int ai = 0; ai < 2; ++ai)
#pragma unroll
            for (int m = 0; m < 4; ++m) {
                const int row = row0 + ai * HALF + m * 16;
                const float r = rt[wr * 64 + fr + ai * HALF + m * 16];
                bf16_t* rowp = O + (size_t)row * ldc + col0;
#pragma unroll
                for (int bj = 0; bj < 2; ++bj) {
                    const f32x4 v0 = acc[ai][bj][m][0] * r, v1 = acc[ai][bj][m][1] * r;
                    u32x4 w; w.x = cvtpk(v0[0], v0[1]); w.y = cvtpk(v0[2], v0[3]); w.z = cvtpk(v1[0], v1[1]); w.w = cvtpk(v1[2], v1[3]);
                    *(u32x4*)(rowp + bj * HALF) = w;
                }
            }
    }
};
struct EpiRes {
    static constexpr bool PRE = false;
    bf16_t* HB; float* ssout;
    __device__ __forceinline__ void operator()(const f32x4 (&acc)[2][2][4][2], const Unit& u, const LAS float*, int wr, int wc, int fr, int fq) const {
        const int row0 = u.pm * BM + wr * 64 + fr, col0 = u.pn * BM + wc * 32 + 8 * fq;
#pragma unroll
        for (int ai = 0; ai < 2; ++ai) {
            u32x4 rv[4][2];
#pragma unroll
            for (int m = 0; m < 4; ++m)
#pragma unroll
                for (int bj = 0; bj < 2; ++bj) rv[m][bj] = *(const u32x4*)(HB + (size_t)(row0 + ai * HALF + m * 16) * D + col0 + bj * HALF);
            __builtin_amdgcn_sched_barrier(0);
#pragma unroll
            for (int m = 0; m < 4; ++m) {
                const int row = row0 + ai * HALF + m * 16;
                float sq = 0.f;
#pragma unroll
                for (int bj = 0; bj < 2; ++bj) {
                    const size_t off = (size_t)row * D + col0 + bj * HALF;
                    const u32x4 r = rv[m][bj];
                    const f32x4 v0 = acc[ai][bj][m][0] + (f32x4){bflo(r.x), bfhi(r.x), bflo(r.y), bfhi(r.y)}, v1 = acc[ai][bj][m][1] + (f32x4){bflo(r.z), bfhi(r.z), bflo(r.w), bfhi(r.w)};
                    u32x4 w; w.x = cvtpk(v0[0], v0[1]); w.y = cvtpk(v0[2], v0[3]); w.z = cvtpk(v1[0], v1[1]); w.w = cvtpk(v1[2], v1[3]);
                    *(u32x4*)(HB + off) = w;
                    sq += v0[0] * v0[0] + v0[1] * v0[1] + v0[2] * v0[2] + v0[3] * v0[3] + v1[0] * v1[0] + v1[1] * v1[1] + v1[2] * v1[2] + v1[3] * v1[3];
                }
                sq += shx(sq, 16, fr + 16 * fq); sq += shx(sq, 32, fr + 16 * fq);
                if (fq == 0) ssout[(size_t)row * 16 + u.pn * 4 + wc] = sq;
            }
            __builtin_amdgcn_sched_barrier(0);
        }
    }
};
struct EpiGlu {
    static constexpr bool PRE = true;
    bf16_t* O; const float* ss;
    __device__ __forceinline__ void operator()(const f32x4 (&acc)[2][2][4][2], const Unit& u, const LAS float* rt, int wr, int wc, int fr, int fq) const {
        const int row0 = u.pm * BM + wr * 64 + fr, col0 = u.pn * HALF + wc * 32 + 8 * fq;
#pragma unroll
        for (int ai = 0; ai < 2; ++ai)
#pragma unroll
            for (int m = 0; m < 4; ++m) {
                const int row = row0 + ai * HALF + m * 16;
                const float r = rt[wr * 64 + fr + ai * HALF + m * 16];
                float o[8];
#pragma unroll
                for (int n = 0; n < 2; ++n)
#pragma unroll
                    for (int j = 0; j < 4; ++j) { const float g = acc[ai][0][m][n][j] * r, uu = acc[ai][1][m][n][j] * r; o[4 * n + j] = g * fast_sigmoid(g) * uu; }
                u32x4 w; w.x = cvtpk(o[0], o[1]); w.y = cvtpk(o[2], o[3]); w.z = cvtpk(o[4], o[5]); w.w = cvtpk(o[6], o[7]);
                *(u32x4*)(O + (size_t)row * DFF + col0) = w;
            }
    }
};

template <class Epi, int KC>
__device__ __forceinline__ void gemm_phase(const int tid, LAS unsigned char* lds, const Gemm g, const StaticOrder& S, const Epi& E) {
    const int wid = __builtin_amdgcn_readfirstlane(tid >> 6), lane = tid & 63, wr = wid >> 2, wc = wid & 3, fr = lane & 15, fq = lane >> 4;
    constexpr int K = KC, nt = K / BK;
    unsigned voffA[2], voffB[2];
#pragma unroll
    for (int i = 0; i < 2; ++i) { int R, C; stage_rc(tid * 16 + i * 8192, R, C); const int Rb = (R & ~31) + perm32(R & 31);
        voffA[i] = (unsigned)(R * K + C) * 2u; voffB[i] = (unsigned)(Rb * K + C) * 2u; }
    const size_t kstep = (size_t)(BK * 2);
    const size_t hstep = (size_t)HALF * K * 2;
    const size_t tstep = 2 * hstep;
    const unsigned ldsw = (unsigned)wid * 1024u;
    const int aoff = lds_byte(wr * 64 + fr, fq * 8), boff = lds_byte(wc * 32 + fr, fq * 8);
#define PG8_SA(b, h) (((b) * 2 + (h)) * HTB)
#define PG8_SB(b, h) ((4 + (b) * 2 + (h)) * HTB)
#define PG8_STAGE(bufoff, gbase, voff) do { _Pragma("unroll") for (int _i = 0; _i < 2; ++_i) \
        __builtin_amdgcn_global_load_lds((const unsigned*)((const char*)(gbase) + (voff)[_i]), (LAS unsigned*)(lds + (bufoff) + ldsw + _i * 8192), 16, 0, 0); } while (0)
#define PG8_LDA(dst, b, h) do { _Pragma("unroll") for (int m = 0; m < 4; ++m) _Pragma("unroll") for (int k = 0; k < 2; ++k) dst[m][k] = *(const LAS bf16x8*)(lds + PG8_SA(b, h) + aoff + m * 2048 + k * 1024); } while (0)
#define PG8_LDB(dst, b, h) do { _Pragma("unroll") for (int n = 0; n < 2; ++n) _Pragma("unroll") for (int k = 0; k < 2; ++k) dst[n][k] = *(const LAS bf16x8*)(lds + PG8_SB(b, h) + boff + n * 2048 + k * 1024); } while (0)
#define PG8_MMA(ai, bj, At, Bt) do { __builtin_amdgcn_s_setprio(1); _Pragma("unroll") for (int m = 0; m < 4; ++m) _Pragma("unroll") for (int n = 0; n < 2; ++n) _Pragma("unroll") for (int k = 0; k < 2; ++k) \
        acc[ai][bj][m][n] = __builtin_amdgcn_mfma_f32_16x16x32_bf16(Bt[n][k], At[m][k], acc[ai][bj][m][n], 0, 0, 0); __builtin_amdgcn_s_setprio(0); } while (0)
#define PG8_WAIT_V(n) asm volatile("s_waitcnt vmcnt(" #n ")" ::: "memory")
#define PG8_WAIT_L(n) asm volatile("s_waitcnt lgkmcnt(" #n ")" ::: "memory")
#define PG8_BAR __builtin_amdgcn_s_barrier()
#define PG8_SCHED __builtin_amdgcn_sched_barrier(0)
    Unit cur, nxt; int ui = 0;
    if (!S.next(0, cur)) return;
    LAS float* rtab = (LAS float*)(lds + 131072);
    f32x4 acc[2][2][4][2];
#pragma unroll
    for (int a = 0; a < 2; ++a)
#pragma unroll
        for (int b = 0; b < 2; ++b)
#pragma unroll
            for (int m = 0; m < 4; ++m)
#pragma unroll
                for (int n = 0; n < 2; ++n) acc[a][b][m][n] = (f32x4){0.f, 0.f, 0.f, 0.f};
    bf16x8 At[4][2], B0[2][2], B1[2][2];
    const char* cA = (const char*)g.A + (size_t)cur.pm * tstep; const char* cB = (const char*)g.Bt + (size_t)cur.pn * tstep;
    PG8_STAGE(PG8_SB(0, 0), cB, voffB); PG8_STAGE(PG8_SB(0, 1), cB + hstep, voffB); PG8_STAGE(PG8_SA(0, 0), cA, voffA); PG8_STAGE(PG8_SA(0, 1), cA + hstep, voffA);
    if constexpr (Epi::PRE) {
        Unit u2;
        for (int i = 0; S.next(i + (tid >> 8), u2) ; i += 2) rtab[(i + (tid >> 8)) * 256 + (tid & 255)] = row_rstd(E.ss, u2.pm * BM + (tid & 255));
        __syncthreads();
    }
    if (wr == 1) PG8_BAR;
    PG8_WAIT_V(2); PG8_BAR;
    PG8_STAGE(PG8_SB(1, 0), cB + kstep, voffB); PG8_STAGE(PG8_SA(1, 0), cA + kstep, voffA); PG8_STAGE(PG8_SB(1, 1), cB + hstep + kstep, voffB);
    PG8_WAIT_V(6); PG8_BAR;
    for (;;) {
        const bool has_next = S.next(ui + 1, nxt);
        const char* nA = has_next ? (const char*)g.A + (size_t)nxt.pm * tstep : cA; const char* nB = has_next ? (const char*)g.Bt + (size_t)nxt.pn * tstep : cB;
        for (int t = 0; t < nt; t += 2) {
            const bool last = (t == nt - 2);
            const char* a1 = cA + (size_t)(t + 1) * kstep;
            const char* a2 = last ? nA : cA + (size_t)(t + 2) * kstep; const char* b2 = last ? nB : cB + (size_t)(t + 2) * kstep;
            const char* a3 = a2 + kstep; const char* b3 = b2 + kstep;
            PG8_LDB(B0, 0, 0); PG8_LDB(B1, 0, 1); PG8_SCHED; PG8_LDA(At, 0, 0); PG8_STAGE(PG8_SA(1, 1), a1 + hstep, voffA);
            PG8_WAIT_V(8); PG8_WAIT_L(0); PG8_BAR; PG8_MMA(0, 0, At, B0); PG8_MMA(0, 1, At, B1); PG8_BAR; PG8_SCHED;
            PG8_LDA(At, 0, 1); PG8_STAGE(PG8_SB(0, 0), b2, voffB); PG8_STAGE(PG8_SB(0, 1), b2 + hstep, voffB); PG8_STAGE(PG8_SA(0, 0), a2, voffA);
            PG8_WAIT_V(8); PG8_WAIT_L(0); PG8_BAR; PG8_MMA(1, 0, At, B0); PG8_MMA(1, 1, At, B1); PG8_BAR; PG8_SCHED;
            PG8_LDB(B0, 1, 0); PG8_LDB(B1, 1, 1); PG8_SCHED; PG8_LDA(At, 1, 0); PG8_STAGE(PG8_SA(0, 1), a2 + hstep, voffA);
            PG8_WAIT_V(8); PG8_WAIT_L(0); PG8_BAR; PG8_MMA(0, 0, At, B0); PG8_MMA(0, 1, At, B1); PG8_BAR; PG8_SCHED;
            PG8_LDA(At, 1, 1); PG8_STAGE(PG8_SB(1, 0), b3, voffB); PG8_STAGE(PG8_SB(1, 1), b3 + hstep, voffB); PG8_STAGE(PG8_SA(1, 0), a3, voffA);
            PG8_WAIT_V(8); PG8_WAIT_L(0); PG8_BAR; PG8_MMA(1, 0, At, B0); PG8_MMA(1, 1, At, B1); PG8_BAR; PG8_SCHED;
        }
        if (wr == 0) PG8_BAR;
        E(acc, cur, rtab + ui * 256, wr, wc, fr, fq);
        if (!has_next) break;
#pragma unroll
        for (int a = 0; a < 2; ++a)
#pragma unroll
            for (int b = 0; b < 2; ++b)
#pragma unroll
                for (int m = 0; m < 4; ++m)
#pragma unroll
                    for (int n = 0; n < 2; ++n) acc[a][b][m][n] = (f32x4){0.f, 0.f, 0.f, 0.f};
        cur = nxt; cA = nA; cB = nB; ++ui;
        if (wr == 1) PG8_BAR;
    }
    PG8_WAIT_V(0);
    PG8_BAR;
#undef PG8_SA
#undef PG8_SB
#undef PG8_STAGE
#undef PG8_LDA
#undef PG8_LDB
#undef PG8_MMA
#undef PG8_WAIT_V
#undef PG8_WAIT_L
#undef PG8_BAR
#undef PG8_SCHED
}
}

__device__ __forceinline__ int dest_row(int n, int rowmode) { return rowmode == 0 ? n : ((n >> 7) * 256 + (n & 127) + (rowmode == 2 ? 128 : 0)); }
__device__ __forceinline__ void tile_load(const float* W, int ldw, const float* kscale, int k0, int n0, LAS float* scr, int lane, float cs = 1.f) {
    float wv[32];
#pragma unroll
    for (int i = 0; i < 32; ++i) wv[i] = W[(size_t)(k0 + 2 * i + (lane >> 5)) * ldw + n0 + (lane & 31)];
#pragma unroll
    for (int i = 0; i < 32; ++i) { const int kk = 2 * i + (lane >> 5); float v = wv[i] * cs; if (kscale) v *= kscale[k0 + kk]; scr[kk * 33 + (lane & 31)] = v; }
    asm volatile("s_waitcnt lgkmcnt(0)" ::: "memory");
}
__device__ __forceinline__ void tile_store_t(const LAS float* scr, bf16_t* WT, int ldt, int k0, int n0, int rowmode, int lane) {
    const int c = lane & 7;
#pragma unroll
    for (int j = 0; j < 4; ++j) { const int n = (lane >> 3) + 8 * j; const LAS float* s = scr + (8 * c) * 33 + n;
        u32x4 o; o.x = cvtpk(s[0 * 33], s[1 * 33]); o.y = cvtpk(s[2 * 33], s[3 * 33]); o.z = cvtpk(s[4 * 33], s[5 * 33]); o.w = cvtpk(s[6 * 33], s[7 * 33]);
        *(u32x4*)(WT + (size_t)dest_row(n0 + n, rowmode) * ldt + k0 + 8 * c) = o; }
    asm volatile("s_waitcnt lgkmcnt(0)" ::: "memory");
}

constexpr int AT_VP = 288;
constexpr int AT_KS = 0, AT_VS = 18432, AT_BUF = 36864, AT_KMH = 73728, AT_KML = 78080;
__device__ __forceinline__ s16x4 vtr(const LAS unsigned char* p) { return __builtin_bit_cast(s16x4, __builtin_amdgcn_ds_read_tr16_b64_v4i16((LAS s16x4*)p)); }

template <int DQK, bool MOBA>
__device__ __forceinline__ void attn_pass(const int tid, LAS unsigned char* lds, const bf16_t* Pb  , int ld, int qcol, int kcol, int vcol,
                                          int q0, int blk, const bf16_t* kmh, const bf16_t* kml, f32x4 (&O)[2][8], float (&linv)[2]) {
    constexpr int PK = (DQK == 64) ? 160 : 288  , NKS = DQK / 32, KCH = DQK / 8  , NKL = DQK / 64  ;
    const int lane = tid & 63, wid = __builtin_amdgcn_readfirstlane(tid >> 6), l15 = lane & 15, quad = lane >> 4;
    const int qw0 = q0 + 32 * wid;
    bf16x8 Qf[2][NKS];
#pragma unroll
    for (int qt = 0; qt < 2; ++qt)
#pragma unroll
        for (int ks = 0; ks < NKS; ++ks) Qf[qt][ks] = *(const bf16x8*)(Pb + (size_t)(qw0 + 16 * qt + l15) * ld + qcol + 32 * ks + 8 * quad);
    float mu[2] = {0.f, 0.f}, l[2] = {0.f, 0.f};
#pragma unroll
    for (int qt = 0; qt < 2; ++qt)
#pragma unroll
        for (int dt = 0; dt < 8; ++dt) O[qt][dt] = (f32x4){0.f, 0.f, 0.f, 0.f};
    const int nt = MOBA ? 4 * (blk + 1) : 4 * (q0 / 256 + 1);
    u32x4 kreg[NKL], vreg[2];
#define AT_KB(it) (MOBA ? ((it) < 4 ? blk * 256 + 64 * (it) : (((it) >> 2) - 1) * 256 + 64 * ((it) & 3)) : 64 * (it))
    unsigned koff[NKL], voff2[2];
#pragma unroll
    for (int _i = 0; _i < NKL; ++_i) { const int _c = tid + 512 * _i; koff[_i] = (unsigned)(((_c / KCH) * ld + kcol + 8 * (_c % KCH)) * 2); }
#pragma unroll
    for (int _i = 0; _i < 2; ++_i) { const int _c = tid + 512 * _i; voff2[_i] = (unsigned)((((_c >> 4)) * ld + vcol + 8 * (_c & 15)) * 2); }
#define AT_GLOAD(it) do { const char* _tb = (const char*)Pb + (size_t)AT_KB(it) * ld * 2; \
        _Pragma("unroll") for (int _i = 0; _i < NKL; ++_i) kreg[_i] = *(const u32x4*)(_tb + koff[_i]); \
        _Pragma("unroll") for (int _i = 0; _i < 2; ++_i) vreg[_i] = *(const u32x4*)(_tb + voff2[_i]); } while (0)
#define AT_LWRITE(bo) do { \
        _Pragma("unroll") for (int _i = 0; _i < NKL; ++_i) { const int _c = tid + 512 * _i; *(LAS u32x4*)(lds + (bo) + AT_KS + (_c / KCH) * PK + 16 * (_c % KCH)) = kreg[_i]; } \
        _Pragma("unroll") for (int _i = 0; _i < 2; ++_i) { const int _c = tid + 512 * _i; *(LAS u32x4*)(lds + (bo) + AT_VS + (_c >> 4) * AT_VP + 16 * (_c & 15)) = vreg[_i]; } } while (0)

    unsigned sel[2] = {0u, 0u};
    __syncthreads();
    if (MOBA) {
        const int h = tid >> 8, c = tid & 255; const bf16_t* src = h ? kml : kmh;
        *(LAS u32x4*)(lds + (h ? AT_KML : AT_KMH) + (c >> 4) * 272 + 16 * (c & 15)) = *(const u32x4*)(src + (c >> 4) * 128 + 8 * (c & 15));
    }
    AT_GLOAD(0);
    {
        u32x4 kreg2[NKL], vreg2[2];
        const char* _tb1 = (const char*)Pb + (size_t)AT_KB(nt > 1 ? 1 : 0) * ld * 2;
#pragma unroll
        for (int _i = 0; _i < NKL; ++_i) kreg2[_i] = *(const u32x4*)(_tb1 + koff[_i]);
#pragma unroll
        for (int _i = 0; _i < 2; ++_i) vreg2[_i] = *(const u32x4*)(_tb1 + voff2[_i]);
        AT_LWRITE(0);
#pragma unroll
        for (int _i = 0; _i < NKL; ++_i) kreg[_i] = kreg2[_i];
#pragma unroll
        for (int _i = 0; _i < 2; ++_i) vreg[_i] = vreg2[_i];
    }
    __syncthreads();
    if (MOBA) {
        if (blk > 0) {
#pragma unroll
            for (int qt = 0; qt < 2; ++qt) {
                f32x4 G = (f32x4){0.f, 0.f, 0.f, 0.f};
#pragma unroll
                for (int ks = 0; ks < NKS; ++ks) {
                    const bf16x8 ah = *(const LAS bf16x8*)(lds + AT_KMH + l15 * 272 + (32 * ks + 8 * quad) * 2);
                    const bf16x8 al = *(const LAS bf16x8*)(lds + AT_KML + l15 * 272 + (32 * ks + 8 * quad) * 2);
                    G = __builtin_amdgcn_mfma_f32_16x16x32_bf16(ah, Qf[qt][ks], G, 0, 0, 0);
                    G = __builtin_amdgcn_mfma_f32_16x16x32_bf16(al, Qf[qt][ks], G, 0, 0, 0);
                }
                float g16[16];
#pragma unroll
                for (int qq = 0; qq < 4; ++qq)
#pragma unroll
                    for (int j = 0; j < 4; ++j) g16[4 * qq + j] = __shfl(G[j], l15 + 16 * qq);
                unsigned taken = 0u, sb = 0u;
#pragma unroll
                for (int r = 0; r < 3; ++r) {
                    float best = -3e38f; int bi = 0;
#pragma unroll
                    for (int jj = 0; jj < 16; ++jj) { const float v = (jj < blk) ? g16[jj] : -1e30f; if (!((taken >> jj) & 1u) && v > best) { best = v; bi = jj; } }
                    taken |= 1u << bi; if (bi < blk) sb |= 1u << bi;
                }
                sel[qt] = sb;
            }
        }
    }
    for (int it = 0; it < nt; ++it) {
        const int cur = (it & 1) * AT_BUF;
        if (it + 1 < nt) { AT_LWRITE(AT_BUF - cur); if (it + 2 < nt) AT_GLOAD(it + 2); }
        const int kb = AT_KB(it);
        bool causal = false, ok0 = true, ok1 = true, skip = false;
        if (!MOBA || it < 4) { skip = (kb > qw0 + 31); causal = (kb + 63 > qw0); }
        else { const int pb = (it >> 2) - 1; ok0 = (sel[0] >> pb) & 1u; ok1 = (sel[1] >> pb) & 1u; skip = !__any(ok0 || ok1); }
        if (!skip) {
            const int qrel = qw0 + l15 - kb;
            const float ni0 = ok0 ? -mu[0] : -1e30f, ni1 = ok1 ? -mu[1] : -1e30f;
            f32x4 S[4][2];
#pragma unroll
            for (int kt = 0; kt < 4; ++kt) { S[kt][0] = (f32x4){ni0, ni0, ni0, ni0}; S[kt][1] = (f32x4){ni1, ni1, ni1, ni1}; }
            const LAS unsigned char* kbase = lds + cur + AT_KS + l15 * PK + 16 * quad;
            const LAS unsigned char* vb = lds + cur + AT_VS + (4 * quad + (l15 >> 2)) * AT_VP + (4 * (l15 & 3)) * 2;
            bf16x8 kfA[NKS], kfB[NKS];
            constexpr int VG = (DQK == 64) ? 2 : 4, GPA = 8 / VG, NG = 2 * GPA;
            s16x4 vlo[2][VG], vhi[2][VG];
#define AT_KREAD(dst, kt) do { _Pragma("unroll") for (int ks = 0; ks < NKS; ++ks) dst[ks] = *(const LAS bf16x8*)(kbase + (16 * (kt)) * PK + 64 * ks); } while (0)
#define AT_KMMA(src, kt) do { _Pragma("unroll") for (int ks = 0; ks < NKS; ++ks) { \
                S[kt][0] = __builtin_amdgcn_mfma_f32_16x16x32_bf16(src[ks], Qf[0][ks], S[kt][0], 0, 0, 0); \
                S[kt][1] = __builtin_amdgcn_mfma_f32_16x16x32_bf16(src[ks], Qf[1][ks], S[kt][1], 0, 0, 0); } } while (0)
#define AT_VREAD(g, bf) do { _Pragma("unroll") for (int d = 0; d < VG; ++d) { \
                vlo[bf][d] = vtr(vb + (32 * ((g) / GPA)) * AT_VP + 32 * (VG * ((g) % GPA) + d)); vhi[bf][d] = vtr(vb + (32 * ((g) / GPA) + 16) * AT_VP + 32 * (VG * ((g) % GPA) + d)); } } while (0)
#define AT_SB() __builtin_amdgcn_sched_barrier(0)
            AT_KREAD(kfA, 0); AT_KREAD(kfB, 1); AT_SB();
            AT_KMMA(kfA, 0); AT_KREAD(kfA, 2); AT_SB();
            AT_KMMA(kfB, 1); AT_KREAD(kfB, 3); AT_SB();
            AT_KMMA(kfA, 2); AT_VREAD(0, 0); AT_SB();
            AT_KMMA(kfB, 3); AT_SB();
            if (causal) {
#pragma unroll
                for (int qt = 0; qt < 2; ++qt)
#pragma unroll
                    for (int kt = 0; kt < 4; ++kt)
#pragma unroll
                        for (int j = 0; j < 4; ++j) if (16 * kt + 4 * quad + j > qrel + 16 * qt) S[kt][qt][j] = -1e30f;
            }
            if (it == 0) {
#pragma unroll
                for (int qt = 0; qt < 2; ++qt) {
                    float a = fmaxf(fmaxf(S[0][qt][0], S[0][qt][1]), fmaxf(S[0][qt][2], S[0][qt][3]));
#pragma unroll
                    for (int kt = 1; kt < 4; ++kt) a = fmaxf(a, fmaxf(fmaxf(S[kt][qt][0], S[kt][qt][1]), fmaxf(S[kt][qt][2], S[kt][qt][3])));
                    a = fmaxf(a, shx(a, 16, lane)); a = fmaxf(a, shx(a, 32, lane));
                    const float delta = fmaxf(a, -100.f);
                    mu[qt] += delta;
#pragma unroll
                    for (int kt = 0; kt < 4; ++kt) S[kt][qt] = S[kt][qt] - delta;
                }
            }
            bf16x8 Pf[2][2];
#pragma unroll
            for (int qt = 0; qt < 2; ++qt) {
                float rs = 0.f;
#pragma unroll
                for (int kt = 0; kt < 4; ++kt)
#pragma unroll
                    for (int j = 0; j < 4; ++j) { const float p = __builtin_amdgcn_exp2f(S[kt][qt][j]); S[kt][qt][j] = p; rs += p; }
                l[qt] += rs;
#pragma unroll
                for (int a = 0; a < 2; ++a) {
                    u32x4 w; w.x = cvtpk(S[2 * a][qt][0], S[2 * a][qt][1]); w.y = cvtpk(S[2 * a][qt][2], S[2 * a][qt][3]);
                    w.z = cvtpk(S[2 * a + 1][qt][0], S[2 * a + 1][qt][1]); w.w = cvtpk(S[2 * a + 1][qt][2], S[2 * a + 1][qt][3]);
                    Pf[qt][a] = __builtin_bit_cast(bf16x8, w);
                }
            }
            AT_SB();
#pragma unroll
            for (int g = 0; g < NG; ++g) {
                if (g < NG - 1) AT_VREAD(g + 1, (g + 1) & 1);
                AT_SB();
#pragma unroll
                for (int d = 0; d < VG; ++d) {
                    const s16x4 lo = vlo[g & 1][d], hi = vhi[g & 1][d];
                    const bf16x8 vf = (bf16x8){lo[0], lo[1], lo[2], lo[3], hi[0], hi[1], hi[2], hi[3]};
                    const int dt = VG * (g % GPA) + d;
                    O[0][dt] = __builtin_amdgcn_mfma_f32_16x16x32_bf16(vf, Pf[0][g / GPA], O[0][dt], 0, 0, 0);
                    O[1][dt] = __builtin_amdgcn_mfma_f32_16x16x32_bf16(vf, Pf[1][g / GPA], O[1][dt], 0, 0, 0);
                }
                AT_SB();
            }
            if (it > 0) {
                typedef unsigned short us2 __attribute__((ext_vector_type(2)));
                unsigned m16[2];
#pragma unroll
                for (int qt = 0; qt < 2; ++qt) {
                    const u32x4 pa = __builtin_bit_cast(u32x4, Pf[qt][0]), pb = __builtin_bit_cast(u32x4, Pf[qt][1]);
                    us2 m = __builtin_elementwise_max(__builtin_bit_cast(us2, pa.x), __builtin_bit_cast(us2, pa.y));
                    m = __builtin_elementwise_max(m, __builtin_elementwise_max(__builtin_bit_cast(us2, pa.z), __builtin_bit_cast(us2, pa.w)));
                    m = __builtin_elementwise_max(m, __builtin_elementwise_max(__builtin_bit_cast(us2, pb.x), __builtin_bit_cast(us2, pb.y)));
                    m = __builtin_elementwise_max(m, __builtin_elementwise_max(__builtin_bit_cast(us2, pb.z), __builtin_bit_cast(us2, pb.w)));
                    m16[qt] = m.x > m.y ? (unsigned)m.x : (unsigned)m.y;
                }
                if (__any(m16[0] > 0x4380u || m16[1] > 0x4380u)) {
#pragma unroll
                    for (int qt = 0; qt < 2; ++qt) {
                        float pm = __builtin_bit_cast(float, m16[qt] << 16);
                        pm = fmaxf(pm, shx(pm, 16, lane)); pm = fmaxf(pm, shx(pm, 32, lane));
                        const float delta = fmaxf(__builtin_amdgcn_logf(fmaxf(pm, 1.f)), 0.f), alpha = __builtin_amdgcn_exp2f(-delta);
                        mu[qt] += delta; l[qt] *= alpha;
#pragma unroll
                        for (int dt = 0; dt < 8; ++dt) O[qt][dt] = O[qt][dt] * alpha;
                    }
                }
            }
#undef AT_KREAD
#undef AT_KMMA
#undef AT_VREAD
#undef AT_SB
        }
        __syncthreads();
    }
#pragma unroll
    for (int qt = 0; qt < 2; ++qt) { float t = l[qt]; t += shx(t, 16, lane); t += shx(t, 32, lane); linv[qt] = 1.f / t; }
#undef AT_GLOAD
#undef AT_LWRITE
#undef AT_KB
}

__constant__ unsigned char UNIT_TAB[96] = {124, 34, 26, 123, 53, 10, 104, 45, 44, 107, 59, 20, 122, 50, 19, 109, 60, 24, 120, 57, 2, 108, 43, 37, 100, 61, 33, 116, 41, 35, 115, 75, 5, 121, 69, 0, 101, 48, 36, 112, 74, 1, 98, 52, 40, 99, 81, 11, 114, 49, 29, 105, 64, 8, 113, 58, 12, 106, 76, 4, 92, 68, 32, 117, 51, 18, 125, 67, 3, 97, 56, 27, 88, 72, 28, 77, 65, 42, 89, 66, 25, 91, 83, 16, 90, 82, 9, 93, 85, 13, 80, 84, 17, 96, 73, 21};
__device__ __forceinline__ bool deal_unit(int r, int G, int w, int& bh, int& qb) {
    if (G == 256) { if (r >= 3) return false; const unsigned e = UNIT_TAB[(w >> 3) * 3 + r]; qb = (int)(e >> 3); bh = (int)(e & 7u) * 8 + (w & 7); return true; }
    const int u = r * G + ((r & 1) ? (G - 1 - w) : w);
    if (u >= 768) return false;
    qb = 15 - u / 48; bh = u % 48; return true;
}

#define XB_TMO      128
#define XB_XCNT(j)  (256  + 64 * (j))
#define XB_XSUB(j)  (1280 + 64 * (j))
#define XB_XGEN(j)  (2304 + 64 * (j))
#define XB_TOP      3328
#define XB_TOPGEN   3392
#define XCD_BAR_WORDS 3456
#define XB_SPIN_CAP (1u << 22)
__device__ __forceinline__ unsigned xb_ld(unsigned* p)              { return __hip_atomic_load(p, __ATOMIC_RELAXED, __HIP_MEMORY_SCOPE_AGENT); }
__device__ __forceinline__ unsigned xb_add(unsigned* p, unsigned v) { return __hip_atomic_fetch_add(p, v, __ATOMIC_RELAXED, __HIP_MEMORY_SCOPE_AGENT); }
__device__ __forceinline__ unsigned xb_xcc_id() { return (unsigned)__builtin_amdgcn_s_getreg((3 << 11) | 20) & 0xFu; }
#define XB_SPIN(cond, bar) do { unsigned _sp = 0; while (cond) { __builtin_amdgcn_s_sleep(1); \
    if ((++_sp & 255u) == 0u) { if (xb_ld(&(bar)[XB_TMO])) break; if (_sp > XB_SPIN_CAP) { atomicAdd(&(bar)[XB_TMO], 1u); break; } } } } while (0)
struct XcdBarrier { unsigned* bar; unsigned x; volatile LAS unsigned* st; };
__device__ __forceinline__ XcdBarrier xcd_barrier_post(unsigned* bar, volatile LAS unsigned* st, int tid) {
    XcdBarrier b; b.bar = bar; b.x = xb_xcc_id(); b.st = st;
    if (tid == 0) (void)xb_add(&bar[XB_XCNT(b.x)], 1u);
    return b;
}
__device__ __forceinline__ void xcd_barrier_complete(unsigned* bar, unsigned x, unsigned& nloc, unsigned& nx) {
    const unsigned G = gridDim.x * gridDim.y * gridDim.z;
    unsigned sum, cnt, mine, sp = 0u;
    for (;;) {
        sum = 0u; cnt = 0u; mine = 0u;
#pragma unroll
        for (unsigned j = 0; j < 16; ++j) { const unsigned c = xb_ld(&bar[XB_XCNT(j)]); sum += c; cnt += (c > 0u) ? 1u : 0u; mine = (j == x) ? c : mine; }
        if (sum == G) break;
        __builtin_amdgcn_s_sleep(1);
        if ((++sp & 255u) == 0u) { if (xb_ld(&bar[XB_TMO])) break; if (sp > XB_SPIN_CAP) { atomicAdd(&bar[XB_TMO], 1u); break; } }
    }
    nloc = mine > 0u ? mine : 1u; nx = cnt > 0u ? cnt : 1u;
}
__device__ __forceinline__ void xcd_barrier(const XcdBarrier& b, int tid) {
    asm volatile("s_waitcnt vmcnt(0)" ::: "memory");
    __syncthreads();
    if (tid == 0) {
        unsigned* bar = b.bar;
        __builtin_amdgcn_s_waitcnt(0);
        unsigned nloc = b.st[0], nx = b.st[1];
        if (nloc == 0u) { xcd_barrier_complete(bar, b.x, nloc, nx); b.st[0] = nloc; b.st[1] = nx; }
        const unsigned old = xb_add(&bar[XB_XSUB(b.x)], 1u);
        const unsigned gen = old / nloc;
        if (old + 1u == (gen + 1u) * nloc) {
            __builtin_amdgcn_fence(__ATOMIC_RELEASE, "agent");
            asm volatile("s_waitcnt vmcnt(0)" ::: "memory");
            const unsigned og = xb_add(&bar[XB_TOP], 1u);
            const unsigned tg = og / nx;
            if (og + 1u == (tg + 1u) * nx) xb_add(&bar[XB_TOPGEN], 1u);
            else XB_SPIN(xb_ld(&bar[XB_TOPGEN]) == tg, bar);
            __builtin_amdgcn_fence(__ATOMIC_ACQUIRE, "agent");
            xb_add(&bar[XB_XGEN(b.x)], 1u);
            asm volatile("s_waitcnt vmcnt(0)" ::: "memory");
        } else {
            XB_SPIN(xb_ld(&bar[XB_XGEN(b.x)]) == gen, bar);
            __builtin_amdgcn_fence(__ATOMIC_ACQUIRE, "agent");
            asm volatile("s_waitcnt vmcnt(0)" ::: "memory");
        }
    }
    __syncthreads();
}

struct Args { const float* in[19]; float* out; unsigned char* ws; int ph_lo, ph_hi; };
constexpr int N_PHASES = 2 + 6 * DEPTH;

__global__ void __launch_bounds__(NTHR, 2) mega_fwd(Args args) {
    extern __shared__ __attribute__((aligned(16))) unsigned char lds_raw[];
    LAS unsigned char* lds = (LAS unsigned char*)lds_raw;
    const int G0 = gridDim.x, wg0 = blockIdx.x, wave0 = __builtin_amdgcn_readfirstlane(threadIdx.x >> 6);
    unsigned char* ws = args.ws;
    float* ss = (float*)(ws + WS_SS);
    bf16_t* hbf = (bf16_t*)(ws + WS_HBF);
    bf16_t* mix = (bf16_t*)(ws + WS_MIX);
    bf16_t* proj = (bf16_t*)(ws + WS_PROJ);
    bf16_t* kmh = (bf16_t*)(ws + WS_KMH);
    bf16_t* kml = (bf16_t*)(ws + WS_KML);
    float* out = args.out;

    volatile LAS unsigned* bst = (volatile LAS unsigned*)(lds + LDS_BYTES - 64);
    volatile LAS unsigned* ptab = (volatile LAS unsigned*)(lds + LDS_BYTES - 256);
    if (threadIdx.x < 2) bst[threadIdx.x] = 0u;
    if (threadIdx.x < 19) { const unsigned long long p = (unsigned long long)args.in[threadIdx.x]; ptab[2 * threadIdx.x] = (unsigned)p; ptab[2 * threadIdx.x + 1] = (unsigned)(p >> 32); }
    __syncthreads();
#define INP(i) ((const float*)(((unsigned long long)(unsigned)__builtin_amdgcn_readfirstlane(ptab[2 * (i) + 1]) << 32) | (unsigned long long)(unsigned)__builtin_amdgcn_readfirstlane(ptab[2 * (i)])))
    XcdBarrier bar = xcd_barrier_post((unsigned*)(ws + WS_BAR), bst, (int)threadIdx.x);
    int rep = 0;
    for (int ph = args.ph_lo; ph < args.ph_hi; ++ph) {
        int tid; asm volatile("v_mbcnt_lo_u32_b32 %0, -1, 0\n\tv_mbcnt_hi_u32_b32 %0, -1, %0" : "=v"(tid)); tid += wave0 * 64;
        int G = G0; asm volatile("" : "+s"(G));
        int wg = wg0; asm volatile("" : "+s"(wg));
        const int lane = tid & 63, wave = __builtin_amdgcn_readfirstlane(tid >> 6), gw = wg * NWAVES + wave, NGW = G * NWAVES;
        const int L = (ph - 1) / 6, k = (ph - 1) % 6, j = L >> 1; const bool AB = !(L & 1);
        unsigned char* wl = ws + WS_W + (size_t)L * WS_WL;
        bool did = true;
        if (ph == 0) {
            LAS float* scr = (LAS float*)(lds + wave * 17408);
            LAS float* scr2 = scr + 64 * 33;
            constexpr int I_AB = 16 * (AB_IN / 32) + 512 + 3 * 1408, I_CD = 16 * (CD_IN / 32) + 512 + 3 * 1408, I_ALL = 2 * (I_AB + I_CD);
            for (int it = gw; it < I_ALL; it += NGW) {
                int r = it, l2 = 0;
                if (r >= I_AB) { r -= I_AB; l2 = 1; if (r >= I_CD) { r -= I_CD; l2 = 2; if (r >= I_AB) { r -= I_AB; l2 = 3; } } }
                const int jj = l2 >> 1; const bool ab = !(l2 & 1);
                unsigned char* wll = ws + WS_W + (size_t)l2 * WS_WL;
                const int NIN = ab ? AB_IN : CD_IN, I_IN = 16 * (NIN / 32);
                if (r < I_IN) {
                    const float* W = ab ? INP(4) + (size_t)jj * D * AB_IN : INP(10) + (size_t)jj * D * CD_IN;
                    const int nblk = NIN / 32, kb = r / nblk, nb = r % nblk;
                    const int n0 = 32 * nb;
                    const float cs = ab ? ((n0 >= 256 && n0 < 1024) ? 0.125f * 1.4426950408889634f : 1.f) : ((n0 >= 512 && n0 < 1280) ? 0.08838834764831845f * 1.4426950408889634f : 1.f);
                    tile_load(W, NIN, INP(1) + l2 * D, 64 * kb, 32 * nb, scr, lane, cs);
                    tile_store_t(scr, (bf16_t*)(wll + WO_IN), D, 64 * kb, 32 * nb, 0, lane);
                    continue;
                }
                r -= I_IN;
                if (r < 512) {
                    const float* W = (ab ? INP(5) : INP(11)) + (size_t)jj * D * D;
                    const int kb = r / 32, nb = r % 32;
                    if (ab && kb < 4) {
                        tile_load(W, D, INP(7) + jj * 256, 64 * kb, 32 * nb, scr, lane);
                        const float* pw = INP(6) + ((size_t)jj * 4 + kb) * 64 * 64;
                        const int nn = lane & 31, ch = lane >> 5;
                        for (int c = 0; c < 32; ++c) {
                            const f32x4* pr = (const f32x4*)(pw + (ch * 32 + c) * 64); float a = 0.f;
#pragma unroll
                            for (int d4 = 0; d4 < 16; ++d4) { const f32x4 p = pr[d4];
                                a += p[0] * scr[(4 * d4) * 33 + nn] + p[1] * scr[(4 * d4 + 1) * 33 + nn] + p[2] * scr[(4 * d4 + 2) * 33 + nn] + p[3] * scr[(4 * d4 + 3) * 33 + nn]; }
                            scr2[(ch * 32 + c) * 33 + nn] = a;
                        }
                        asm volatile("s_waitcnt lgkmcnt(0)" ::: "memory");
                        tile_store_t(scr2, (bf16_t*)(wll + WO_OUT), D, 64 * kb, 32 * nb, 0, lane);
                    } else {
                        tile_load(W, D, nullptr, 64 * kb, 32 * nb, scr, lane);
                        tile_store_t(scr, (bf16_t*)(wll + WO_OUT), D, 64 * kb, 32 * nb, 0, lane);
                    }
                    continue;
                }
                r -= 512;
                if (r < 2 * 1408) {
                    const int up = r >= 1408; if (up) r -= 1408;
                    const float* W = (up ? INP(17) : INP(16)) + (size_t)l2 * D * DFF;
                    const int kb = r / 88, nb = r % 88;
                    tile_load(W, DFF, INP(2) + l2 * D, 64 * kb, 32 * nb, scr, lane);
                    tile_store_t(scr, (bf16_t*)(wll + WO_GU), D, 64 * kb, 32 * nb, up ? 2 : 1, lane);
                    continue;
                }
                r -= 2 * 1408;
                {
                    const float* W = INP(18) + (size_t)l2 * DFF * D;
                    const int kb = r / 32, nb = r % 32;
                    tile_load(W, D, nullptr, 64 * kb, 32 * nb, scr, lane);
                    tile_store_t(scr, (bf16_t*)(wll + WO_D), DFF, 64 * kb, 32 * nb, 0, lane);
                }
            }
            const float* xin = INP(0);
            for (int m0 = gw; m0 < M; m0 += 4 * NGW) {
                f32x4 v[4][4];
#pragma unroll
                for (int rr2 = 0; rr2 < 4; ++rr2) { const int m = (m0 + rr2 * NGW < M) ? m0 + rr2 * NGW : m0; const f32x4* xr = (const f32x4*)(xin + (size_t)m * D) + lane;
#pragma unroll
                    for (int q = 0; q < 4; ++q) v[rr2][q] = xr[64 * q]; }
#pragma unroll
                for (int rr2 = 0; rr2 < 4; ++rr2) { const int m = m0 + rr2 * NGW; if (m < M) {
                    float sm = 0.f;
#pragma unroll
                    for (int q = 0; q < 4; ++q) sm += v[rr2][q][0] * v[rr2][q][0] + v[rr2][q][1] * v[rr2][q][1] + v[rr2][q][2] * v[rr2][q][2] + v[rr2][q][3] * v[rr2][q][3];
                    const float s = wave_sum(sm, lane); if (lane < 4) ((f32x4*)(ss + (size_t)m * 16))[lane] = (f32x4){lane == 0 ? s : 0.f, 0.f, 0.f, 0.f};
                    u32x2* o = (u32x2*)(hbf + (size_t)m * D) + lane;
#pragma unroll
                    for (int q = 0; q < 4; ++q) { u32x2 w; w.x = cvtpk(v[rr2][q][0], v[rr2][q][1]); w.y = cvtpk(v[rr2][q][2], v[rr2][q][3]); o[64 * q] = w; } } }
            }
        } else if (ph == N_PHASES - 1) {
            const float* gf = INP(3); const float* s8 = ss + (size_t)8 * M * 16;
            for (int m0 = gw; m0 < M; m0 += 4 * NGW) {
                u32x2 hv[4][4]; float r4[4];
#pragma unroll
                for (int rr2 = 0; rr2 < 4; ++rr2) { const int m = (m0 + rr2 * NGW < M) ? m0 + rr2 * NGW : m0; r4[rr2] = row_rstd(s8, m);
                    const u32x2* hr = (const u32x2*)(hbf + (size_t)m * D) + lane;
#pragma unroll
                    for (int q = 0; q < 4; ++q) hv[rr2][q] = hr[64 * q]; }
#pragma unroll
                for (int rr2 = 0; rr2 < 4; ++rr2) { const int m = m0 + rr2 * NGW; if (m < M) {
                    f32x4* orow = (f32x4*)(out + (size_t)m * D) + lane;
#pragma unroll
                    for (int q = 0; q < 4; ++q) { const f32x4 g4 = ((const f32x4*)gf)[lane + 64 * q]; const u32x2 h2 = hv[rr2][q];
                        orow[64 * q] = (f32x4){bflo(h2.x), bfhi(h2.x), bflo(h2.y), bfhi(h2.y)} * r4[rr2] * g4; } } }
            }
        } else if (k == 0) {
            const int NIN = AB ? AB_IN : CD_IN;
            pg8::Gemm g{hbf, (const bf16_t*)(wl + WO_IN), M, NIN, D}; pg8::StaticOrder S; S.init(M, NIN, G, wg);
            pg8::EpiProj E{proj, NIN, ss + (size_t)(2 * L) * M * 16};
#ifndef X_NO_PROJ
            pg8::gemm_phase<pg8::EpiProj, D>(tid, lds, g, S, E);
#endif
        } else if (k == 1 && AB) {
#pragma unroll 1
            for (int rr = 0; rr < ((X_SUB & 1) ? 2 : 1); ++rr)
            for (int tok0 = 8 * gw; tok0 < M; tok0 += 8 * NGW) {
                const int t0 = tok0 & (SEQ - 1), w = 2 << (lane >> 4);
                const bf16_t* base = proj + (size_t)tok0 * AB_IN + 4 * lane;
                u32x2 v[23];
#pragma unroll
                for (int r = 0; r < 23; ++r) { const int d = r - 15; v[r] = *(const u32x2*)(base + (ptrdiff_t)((t0 + d >= 0) ? d : -t0) * AB_IN); }
#pragma unroll
                for (int i = 0; i < 8; ++i) {
                    const int cnt = (t0 + i + 1 < w) ? t0 + i + 1 : w;
                    const float c0 = bflo(v[15 + i].x), c1 = bfhi(v[15 + i].x), c2_ = bflo(v[15 + i].y), c3 = bfhi(v[15 + i].y);
                    float s0 = c0, s1 = c1, s2 = c2_, s3 = c3;
#pragma unroll
                    for (int q = 1; q < 16; ++q) { const float wq = (q < cnt) ? 1.f : 0.f; const u32x2 u = v[15 + i - q]; s0 += wq * bflo(u.x); s1 += wq * bfhi(u.x); s2 += wq * bflo(u.y); s3 += wq * bfhi(u.y); }
                    const float inv = 1.f / (float)cnt;
                    u32x2 o; o.x = cvtpk(s0 * inv - c0, s1 * inv - c1); o.y = cvtpk(s2 * inv - c2_, s3 * inv - c3);
                    *(u32x2*)(mix + (size_t)(tok0 + i) * D + 4 * lane) = o;
                }
            }
#ifndef X_NO_DIFF
            const float* lp = INP(8) + (size_t)j * 4 * 64;
            const float lam_init = (L == 0) ? 0.2f : 0.47071301834358416f;
            const float lam = __expf(wave_sum(lp[lane] * lp[64 + lane], lane)) - __expf(wave_sum(lp[128 + lane] * lp[192 + lane], lane)) + lam_init;
            const float* sg = INP(9) + (size_t)j * 128;
#pragma unroll 1
            for (int rr = 0; rr < ((X_SUB & 2) ? 2 : 1); ++rr)
            for (int r = 0;; ++r) {
                int bh, qb; if (!deal_unit(r, G, wg, bh, qb)) break;
                const int b = bh / 6, h = bh % 6;
                const bf16_t* Pb = proj + (size_t)b * SEQ * AB_IN;
#pragma unroll 1
                for (int map = 0; map < 2; ++map) {
                    int tu = tid; asm volatile("" : "+v"(tu));
                    const int l15 = tu & 15, quad = (tu & 63) >> 4;
                    f32x4* o1s = (f32x4*)(ws + WS_O1) + (size_t)wg * 16 * NTHR + tu;
                    f32x4 O[2][8]; float li[2];
                    attn_pass<64, false>(tu, lds, Pb, AB_IN, 256 + (2 * h + map) * 64, 1024 + (2 * h + map) * 64, 1792 + h * 128, qb * 256, 0, nullptr, nullptr, O, li);
                    if (map == 0) {
#pragma unroll
                        for (int qt = 0; qt < 2; ++qt)
#pragma unroll
                            for (int dt = 0; dt < 8; ++dt) o1s[(qt * 8 + dt) * NTHR] = O[qt][dt] * li[qt];
                    } else {
#pragma unroll
                        for (int qt = 0; qt < 2; ++qt) {
                            float sq = 0.f; const float f = lam * li[qt];
#pragma unroll
                            for (int dt = 0; dt < 8; ++dt) { O[qt][dt] = o1s[(qt * 8 + dt) * NTHR] - O[qt][dt] * f; const f32x4 v = O[qt][dt]; sq += v[0] * v[0] + v[1] * v[1] + v[2] * v[2] + v[3] * v[3]; }
                            sq += shx(sq, 16, tu & 63); sq += shx(sq, 32, tu & 63);
                            const float rn = __builtin_amdgcn_rsqf(sq * (1.f / 128.f) + EPS) * (1.f - lam_init);
                            const float* sgp = sg; asm volatile("" : "+s"(sgp));
                            bf16_t* orow = mix + (size_t)(b * SEQ + qb * 256 + 32 * wave + 16 * qt + l15) * D + 256 + h * 128 + 4 * quad;
#pragma unroll
                            for (int dt = 0; dt < 8; ++dt) { const f32x4 g4 = *(const f32x4*)(sgp + 16 * dt + 4 * quad); const f32x4 v = O[qt][dt] * rn * g4;
                                u32x2 w; w.x = cvtpk(v[0], v[1]); w.y = cvtpk(v[2], v[3]); *(u32x2*)(orow + 16 * dt) = w; }
                        }
                    }
                }
            }
#endif
        } else if (k == 1 && !AB) {
            LAS float* red = (LAS float*)lds;
#pragma unroll 1
            for (int rr = 0; rr < ((X_SUB & 4) ? 2 : 1); ++rr) {
            for (int it0 = wg; it0 < 768; it0 += 3 * G) {
                unsigned kv[3][32];
#pragma unroll
                for (int j3 = 0; j3 < 3; ++j3) {
                    const int it = (it0 + j3 * G < 768) ? it0 + j3 * G : it0;
                    const int b = it / 96, hh = (it / 16) % 6, blk = it & 15;
                    const bf16_t* kp = proj + (size_t)(b * SEQ + blk * 256 + 32 * wave) * CD_IN + 1280 + hh * 128 + 2 * lane;
#pragma unroll
                    for (int r = 0; r < 32; ++r) kv[j3][r] = *(const unsigned*)(kp + (size_t)r * CD_IN);
                }
#pragma unroll
                for (int j3 = 0; j3 < 3; ++j3) {
                    const int it = it0 + j3 * G;
                    float a0 = 0.f, a1 = 0.f;
#pragma unroll
                    for (int r = 0; r < 32; ++r) { a0 += bflo(kv[j3][r]); a1 += bfhi(kv[j3][r]); }
                    __syncthreads();
                    red[wave * 128 + 2 * lane] = a0; red[wave * 128 + 2 * lane + 1] = a1;
                    __syncthreads();
                    if (it < 768 && tid < 128) { float s = 0.f;
#pragma unroll
                        for (int w = 0; w < 8; ++w) s += red[w * 128 + tid];
                        s *= (1.f / 256.f);
                        const unsigned hi = cvtpk(s, 0.f) & 0xffffu; const float hf = __builtin_bit_cast(float, hi << 16);
                        const unsigned lo = cvtpk(s - hf, 0.f) & 0xffffu;
                        kmh[(size_t)it * 128 + tid] = (bf16_t)hi; kml[(size_t)it * 128 + tid] = (bf16_t)lo; }
                }
            }
            {
                LAS float* hp = (LAS float*)lds;
                LAS float* cw = (LAS float*)(lds + 94 * 1024);
                const float* convw = INP(12) + (size_t)j * 31 * 256;
                const float* convb = INP(13) + (size_t)j * 256; const float* lng = INP(14) + (size_t)j * 256; const float* lnb = INP(15) + (size_t)j * 256;
                for (int u = wg; u < 512; u += G) {
                    const int b = u >> 6, t0 = (u & 63) * 64;
                    __syncthreads();
                    for (int i = tid; i < 31 * 64; i += NTHR) ((LAS f32x4*)cw)[i] = ((const f32x4*)convw)[i];
                    {
                        const int c4 = tid & 63;
                        u32x2 av[12], gv[12];
#pragma unroll
                        for (int p = 0; p < 12; ++p) {
                            int r = 8 * p + (tid >> 6); r = r < 94 ? r : 93; int t = t0 - 30 + r; t = t > 0 ? t : 0;
                            const bf16_t* up = proj + (size_t)(b * SEQ + t) * CD_IN + 4 * c4;
                            av[p] = *(const u32x2*)up; gv[p] = *(const u32x2*)(up + 256);
                        }
#pragma unroll
                        for (int p = 0; p < 12; ++p) {
                            const int r = 8 * p + (tid >> 6), t = t0 - 30 + r;
                            if (r < 94) {
                                f32x4 hv = (f32x4){0.f, 0.f, 0.f, 0.f};
                                if (t >= 0) {
                                    const u32x2 a = av[p], gt = gv[p];
                                    hv[0] = bflo(a.x) * fast_sigmoid(bflo(gt.x)); hv[1] = bfhi(a.x) * fast_sigmoid(bfhi(gt.x));
                                    hv[2] = bflo(a.y) * fast_sigmoid(bflo(gt.y)); hv[3] = bfhi(a.y) * fast_sigmoid(bfhi(gt.y));
                                }
                                *(LAS f32x4*)(hp + r * 256 + 4 * c4) = hv;
                            }
                        }
                    }
                    __syncthreads();
                    const f32x4 bias = *(const f32x4*)(convb + 4 * lane), g4 = *(const f32x4*)(lng + 4 * lane), b4 = *(const f32x4*)(lnb + 4 * lane);
                    f32x4 a8[8];
#pragma unroll
                    for (int i = 0; i < 8; ++i) a8[i] = bias;
#pragma unroll 8
                    for (int q = 0; q < 31; ++q) {
                        const f32x4 wq = *(const LAS f32x4*)(cw + q * 256 + 4 * lane);
#pragma unroll
                        for (int i = 0; i < 8; ++i) a8[i] += wq * *(const LAS f32x4*)(hp + (8 * wave + i + q) * 256 + 4 * lane);
                    }
#pragma unroll
                    for (int i = 0; i < 8; ++i) {
                        const f32x4 a = a8[i];
                        const float mu = wave_sum(a[0] + a[1] + a[2] + a[3], lane) * (1.f / 256.f);
                        const f32x4 dlt = a - mu;
                        const float var = wave_sum(dlt[0] * dlt[0] + dlt[1] * dlt[1] + dlt[2] * dlt[2] + dlt[3] * dlt[3], lane) * (1.f / 256.f);
                        const float rs = __builtin_amdgcn_rsqf(var + EPS);
                        f32x4 y = dlt * rs * g4 + b4;
#pragma unroll
                        for (int q = 0; q < 4; ++q) y[q] = y[q] * fast_sigmoid(y[q]);
                        u32x2 o; o.x = cvtpk(y[0], y[1]); o.y = cvtpk(y[2], y[3]);
                        *(u32x2*)(mix + (size_t)(b * SEQ + t0 + 8 * wave + i) * D + 4 * lane) = o;
                    }
                }
            }
            __syncthreads();
            }
        } else if (k == 2) {
            if (AB) did = false;
            else {
#ifndef X_NO_MOBA
#pragma unroll 1
                for (int rr = 0; rr < ((X_SUB & 8) ? 2 : 1); ++rr)
                for (int r = 0;; ++r) {
                    int bh, qb; if (!deal_unit(r, G, wg, bh, qb)) break;
                    const int b = bh / 6, h = bh % 6;
                    const bf16_t* Pb = proj + (size_t)b * SEQ * CD_IN;
                    int tu = tid; asm volatile("" : "+v"(tu));
                    const int l15 = tu & 15, quad = (tu & 63) >> 4;
                    f32x4 O[2][8]; float li[2];
                    attn_pass<128, true>(tu, lds, Pb, CD_IN, 512 + h * 128, 1280 + h * 128, 2048 + h * 128, qb * 256, qb, kmh + (size_t)bh * 16 * 128, kml + (size_t)bh * 16 * 128, O, li);
#pragma unroll
                    for (int qt = 0; qt < 2; ++qt) {
                        bf16_t* orow = mix + (size_t)(b * SEQ + qb * 256 + 32 * wave + 16 * qt + l15) * D + 256 + h * 128 + 4 * quad;
#pragma unroll
                        for (int dt = 0; dt < 8; ++dt) { const f32x4 v = O[qt][dt] * li[qt]; u32x2 w; w.x = cvtpk(v[0], v[1]); w.y = cvtpk(v[2], v[3]); *(u32x2*)(orow + 16 * dt) = w; }
                    }
                }
#endif
            }
        } else if (k == 3 || k == 5) {
            const bool dn = (k == 5);
            pg8::Gemm g{dn ? proj : mix, (const bf16_t*)(wl + (dn ? WO_D : WO_OUT)), M, D, dn ? DFF : D}; pg8::StaticOrder S; S.init(M, D, G, wg);
            pg8::EpiRes E{hbf, ss + (size_t)(2 * L + (dn ? 2 : 1)) * M * 16};
#ifndef X_NO_RES
            if (dn) pg8::gemm_phase<pg8::EpiRes, DFF>(tid, lds, g, S, E); else pg8::gemm_phase<pg8::EpiRes, D>(tid, lds, g, S, E);
#endif
        } else {
            pg8::Gemm g{hbf, (const bf16_t*)(wl + WO_GU), M, 2 * DFF, D}; pg8::StaticOrder S; S.init(M, 2 * DFF, G, wg);
            pg8::EpiGlu E{proj, ss + (size_t)(2 * L + 1) * M * 16};
#ifndef X_NO_GLU
            pg8::gemm_phase<pg8::EpiGlu, D>(tid, lds, g, S, E);
#endif
        }
        if (X_REP && X_REP < 256 && did && ph >= 1 && ph < N_PHASES - 1 && ((X_REP >> k) & 1) && rep == 0) { rep = 1; xcd_barrier(bar, tid); --ph; continue; }
        rep = 0;
        if (did && ph + 1 < args.ph_hi) {
            if (args.ph_lo == 0x7fffffff) cg::this_grid().sync();
            xcd_barrier(bar, tid);
        }
    }
}

extern "C" void kernel_launch(void* const* d_in, const int* in_sizes, int n_in, void* d_out, int out_size, void* d_ws, size_t ws_size, hipStream_t stream) {
    static int grid = 0;
    if (grid == 0) {
        if (n_in != 19 || in_sizes[0] != M * D || out_size != M * D || ws_size < WS_END) { fprintf(stderr, "kernel_launch: unexpected shapes (n_in %d, in0 %d, out %d, ws %zu)\n", n_in, n_in > 0 ? in_sizes[0] : -1, out_size, ws_size); grid = -1; return; }
        int dev = 0, cus = 0, per_cu = 0;
        hipGetDevice(&dev); hipDeviceGetAttribute(&cus, hipDeviceAttributeMultiprocessorCount, dev);
        if (hipFuncSetAttribute((const void*)mega_fwd, hipFuncAttributeMaxDynamicSharedMemorySize, LDS_BYTES) != hipSuccess) { fprintf(stderr, "kernel_launch: hipFuncSetAttribute failed\n"); grid = -1; return; }
        if (hipOccupancyMaxActiveBlocksPerMultiprocessor(&per_cu, (const void*)mega_fwd, NTHR, LDS_BYTES) != hipSuccess || per_cu < 1) { fprintf(stderr, "kernel_launch: occupancy query gave %d\n", per_cu); per_cu = 1; }
        (void)hipGetLastError();
        grid = cus * (per_cu > 1 ? 1 : per_cu);
        if (grid <= 0 || grid > 256) grid = 256;
    }
    if (grid < 0) return;
    Args a{};
    for (int i = 0; i < 19; ++i) a.in[i] = (const float*)d_in[i];
    a.out = (float*)d_out; a.ws = (unsigned char*)d_ws;
#if MK_MULTI
    for (int ph = 0; ph < N_PHASES; ++ph) {
        if (ph >= 1 && ph < N_PHASES - 1 && ((ph - 1) % 6) == 2 && (((ph - 1) / 6) & 1) == 0) continue;
        a.ph_lo = ph; a.ph_hi = ph + 1;
        hipLaunchKernelGGL(mega_fwd, dim3(grid), dim3(NTHR), LDS_BYTES, stream, a);
    }
#else
    a.ph_lo = 0; a.ph_hi = N_PHASES;
    if (hipMemsetAsync((char*)d_ws + WS_BAR, 0, XCD_BAR_WORDS * 4, stream) != hipSuccess) { fprintf(stderr, "kernel_launch: hipMemsetAsync failed\n"); return; }
    void* kargs[] = {&a};
    hipError_t e = hipLaunchCooperativeKernel((const void*)mega_fwd, dim3(grid), dim3(NTHR), kargs, LDS_BYTES, stream);
    if (e != hipSuccess) fprintf(stderr, "kernel_launch: cooperative launch failed: %s (grid %d)\n", hipGetErrorString(e), grid);
#endif
}
```
